# Optimizing an MI355X kernel written in HIP

```python
import jax, jax.numpy as jnp
from jax import lax
import numpy as np

D_MODEL = 2048
BATCH = 4
SEQ = 8192
DEPTH = 1
DEC_BATCH = 8
DEC_SEQ = 64
PAST_LEN = 1024

CHUNK = 64
WINDOW = 128
WIN_CHUNKS = WINDOW // CHUNK
SWA_HEADS = 16
SWA_KV_HEADS = 4
SWA_GROUP = SWA_HEADS // SWA_KV_HEADS
SWA_HEAD_DIM = 64
RET_HEADS = 8
RET_QK_DIM = 128
RET_V_DIM = 128
RET_ROPE_BASE = 10000.0
N_MEM = 256
MEM_HEADS = 4
MEM_HEAD_DIM = 256
D_FF = 5632
CONV_W = 3
N_BRANCH = 3
EPS = 1e-6
NEG = -1e30

SWA_Q = SWA_HEADS * SWA_HEAD_DIM
SWA_KV = SWA_KV_HEADS * SWA_HEAD_DIM
RET_QK = RET_HEADS * RET_QK_DIM
RET_V = RET_HEADS * RET_V_DIM
MEM_W = MEM_HEADS * MEM_HEAD_DIM
IN_SPLITS = (SWA_Q, SWA_KV, SWA_KV, RET_QK, RET_QK, RET_V, RET_V, MEM_W, N_BRANCH * D_MODEL)
IN_COLS = sum(IN_SPLITS)
MIX_W = SWA_Q + RET_V + MEM_W

kernel_name = "hybrid_streaming_swa_retention_step"


def rmsnorm(x, g):
    xf = x.astype(jnp.float32)
    y = xf * lax.rsqrt(jnp.mean(xf * xf, axis=-1, keepdims=True) + EPS)
    return (y * g.astype(jnp.float32)).astype(x.dtype)


def rotary(x, pos):
    half = x.shape[-1] // 2
    inv_freq = 1.0 / (RET_ROPE_BASE ** jnp.linspace(0.0, 1.0, half, dtype=jnp.float32))
    ang = pos.astype(jnp.float32)[:, None] * inv_freq[None, :]
    cos = jnp.cos(ang)[None, :, None, :]
    sin = jnp.sin(ang)[None, :, None, :]
    xf = x.astype(jnp.float32)
    x1, x2 = xf[..., :half], xf[..., half:]
    return jnp.concatenate([x1 * cos - x2 * sin, x1 * sin + x2 * cos], axis=-1).astype(x.dtype)


def sink_softmax(s, sink):
    sk = sink.astype(jnp.float32)[:, :, None, None]
    m = jnp.maximum(jnp.max(s, axis=-1, keepdims=True), sk)
    p = jnp.exp(s - m)
    return p / (jnp.sum(p, axis=-1, keepdims=True) + jnp.exp(sk - m))


def swa_banded(q, k, v, sink):
    B, S = q.shape[:2]
    nc = S // CHUNK
    qb = q.reshape(B, nc, CHUNK, SWA_KV_HEADS, SWA_GROUP, SWA_HEAD_DIM)

    def band(x):
        xb = jnp.pad(x.reshape(B, nc, CHUNK, SWA_KV_HEADS, SWA_HEAD_DIM),
                     ((0, 0), (WIN_CHUNKS, 0), (0, 0), (0, 0), (0, 0)))
        return jnp.concatenate([xb[:, j:j + nc] for j in range(WIN_CHUNKS + 1)], axis=2)

    kb, vb = band(k), band(v)
    chunk_id = jnp.arange(nc)[:, None] - WIN_CHUNKS + jnp.arange(WIN_CHUNKS + 1)[None, :]
    valid = jnp.repeat(chunk_id >= 0, CHUNK, axis=1)
    s = jnp.einsum('bnqhgd,bnkhd->bnhgqk', qb, kb).astype(jnp.float32) * (SWA_HEAD_DIM ** -0.5)
    s = jnp.where(valid[None, :, None, None, None, :], s, NEG)
    p = sink_softmax(s, sink.reshape(SWA_KV_HEADS, SWA_GROUP)).astype(v.dtype)
    o = jnp.einsum('bnhgqk,bnkhd->bnqhgd', p, vb)
    return o.reshape(B, S, SWA_Q)


def swa_step(q, k_all, v_all, sink):
    B, T = q.shape[:2]
    qg = q.reshape(B, T, SWA_KV_HEADS, SWA_GROUP, SWA_HEAD_DIM)
    s = jnp.einsum('bqhgd,bkhd->bhgqk', qg, k_all).astype(jnp.float32) * (SWA_HEAD_DIM ** -0.5)
    p = sink_softmax(s, sink.reshape(SWA_KV_HEADS, SWA_GROUP)).astype(v_all.dtype)
    o = jnp.einsum('bhgqk,bkhd->bqhgd', p, v_all)
    return o.reshape(B, T, SWA_Q)


def ret_log_decay():
    return jnp.log1p(-jnp.exp2(-5.0 - jnp.arange(RET_HEADS, dtype=jnp.float32)))


def retention_chunk(q, k, v, state):
    C = q.shape[2]
    log_g = ret_log_decay()
    n = jnp.arange(C, dtype=jnp.float32)
    diff = n[:, None] - n[None, :]
    decay = jnp.where(diff >= 0, jnp.exp(log_g[:, None, None] * jnp.maximum(diff, 0.0)), 0.0)
    qf, kf, vf, sf = (a.astype(jnp.float32) for a in (q, k, v, state))
    inner = jnp.einsum('bhnd,bhmd->bhnm', qf, kf) * decay
    o = jnp.einsum('bhnm,bhme->bhne', inner, vf)
    o = o + jnp.einsum('bhnd,bhde->bhne', qf, sf) * jnp.exp(log_g[:, None] * (n + 1.0))[:, :, None]
    zeta = jnp.exp(log_g[:, None] * (C - 1.0 - n))
    new_state = (jnp.exp(log_g * C)[:, None, None] * sf
                 + jnp.einsum('bhmd,bhme->bhde', kf * zeta[:, :, None], vf))
    return o, new_state


def retention_chunked(q, k, v):
    B, H, S, _ = q.shape
    nc = S // CHUNK

    def blocks(a):
        return jnp.moveaxis(a.reshape(B, H, nc, CHUNK, a.shape[-1]), 2, 0)

    def step(state, qkv):
        o, state = retention_chunk(qkv[0], qkv[1], qkv[2], state)
        return state, o

    s0 = jnp.zeros((B, H, RET_QK_DIM, RET_V_DIM), jnp.float32)
    s_final, o = lax.scan(step, s0, (blocks(q), blocks(k), blocks(v)))
    return jnp.moveaxis(o, 0, 2).reshape(B, H, S, RET_V_DIM), s_final


def retention_out(o, gate):
    B, H, T, _ = o.shape
    o = o * lax.rsqrt(jnp.mean(o * o, axis=-1, keepdims=True) + EPS)
    o = jnp.transpose(o, (0, 2, 1, 3)).reshape(B, T, RET_V)
    return (jax.nn.silu(gate.astype(jnp.float32)) * o).astype(gate.dtype)


def memory_kv(mem, g_mem, w_mem_kv):
    B, M, _ = mem.shape
    k, v = jnp.split(rmsnorm(mem, g_mem) @ w_mem_kv, 2, axis=-1)
    return (k.reshape(B, M, MEM_HEADS, MEM_HEAD_DIM), v.reshape(B, M, MEM_HEADS, MEM_HEAD_DIM))


def memory_attend(q, mk, mv):
    B, T = q.shape[:2]
    qh = q.reshape(B, T, MEM_HEADS, MEM_HEAD_DIM)
    s = jnp.einsum('bthd,bmhd->bhtm', qh, mk).astype(jnp.float32) * (MEM_HEAD_DIM ** -0.5)
    p = jax.nn.softmax(s, axis=-1).astype(mv.dtype)
    return jnp.einsum('bhtm,bmhd->bthd', p, mv).reshape(B, T, MEM_W)


def conv_ffn(u, conv_buf, w_up, w_conv, b_conv, w_down):
    T = u.shape[1]
    a = u @ w_up
    ext = jnp.concatenate([conv_buf.astype(a.dtype), a], axis=1)
    c = b_conv + sum(ext[:, j:j + T] * w_conv[j] for j in range(CONV_W))
    g, val = jnp.split(c, 2, axis=-1)
    return (jax.nn.silu(g) * val) @ w_down, ext[:, T:]


def run_layer(h, pos, mem_k, mem_v, swa_cache, ret_state, conv_buf,
              g_mix, w_in, b_gate, sink, w_br, w_o, g_ffn, w_up, w_conv, b_conv, w_down):
    B, T, _ = h.shape
    u = rmsnorm(h, g_mix)
    split_pts = np.cumsum(IN_SPLITS)[:-1].tolist()
    qa, ka, va, qr, kr, vr, gr, qm, gl = jnp.split(u @ w_in, split_pts, axis=-1)
    qa = qa.reshape(B, T, SWA_HEADS, SWA_HEAD_DIM)
    ka = ka.reshape(B, T, SWA_KV_HEADS, SWA_HEAD_DIM)
    va = va.reshape(B, T, SWA_KV_HEADS, SWA_HEAD_DIM)
    if swa_cache is None:
        o_swa = swa_banded(qa, ka, va, sink)
        new_k, new_v = ka[:, -WINDOW:], va[:, -WINDOW:]
    else:
        k_all = jnp.concatenate([swa_cache[0].astype(ka.dtype), ka], axis=1)
        v_all = jnp.concatenate([swa_cache[1].astype(va.dtype), va], axis=1)
        o_swa = swa_step(qa, k_all, v_all, sink)
        n_keep = swa_cache[0].shape[1]
        new_k, new_v = k_all[:, -n_keep:], v_all[:, -n_keep:]
    qr = rotary(qr.reshape(B, T, RET_HEADS, RET_QK_DIM), pos)
    kr = rotary(kr.reshape(B, T, RET_HEADS, RET_QK_DIM), pos) * (RET_QK_DIM ** -0.5)
    vr = vr.reshape(B, T, RET_HEADS, RET_V_DIM)
    qt, kt, vt = (jnp.transpose(a, (0, 2, 1, 3)) for a in (qr, kr, vr))
    if ret_state is None:
        o_r, s_new = retention_chunked(qt, kt, vt)
    else:
        o_r, s_new = retention_chunk(qt, kt, vt, ret_state)
    o_ret = retention_out(o_r, gr)
    o_mem = memory_attend(qm, mem_k.astype(h.dtype), mem_v.astype(h.dtype))
    gates = jax.nn.sigmoid((gl + b_gate).astype(jnp.float32)).astype(h.dtype).reshape(B, T, N_BRANCH, D_MODEL)
    merged = (gates[:, :, 0] * (o_swa @ w_br[:SWA_Q])
              + gates[:, :, 1] * (o_ret @ w_br[SWA_Q:SWA_Q + RET_V])
              + gates[:, :, 2] * (o_mem @ w_br[SWA_Q + RET_V:]))
    h = h + merged @ w_o
    f, new_buf = conv_ffn(rmsnorm(h, g_ffn), conv_buf, w_up, w_conv, b_conv, w_down)
    return h + f, new_k, new_v, s_new.astype(h.dtype), new_buf


def setup_inputs(seed: int = 0) -> dict:
    key = jax.random.key(seed)
    ks = jax.random.split(key, 24)
    f32 = jnp.float32

    def nrm(k, shape, scale):
        return jax.random.normal(k, shape, f32) * scale

    swa_len = min(WINDOW, PAST_LEN)
    return {
        "x_prompt": nrm(ks[0], (BATCH, SEQ, D_MODEL), 1.0),
        "x_sample": nrm(ks[1], (DEC_BATCH, DEC_SEQ, D_MODEL), 1.0),
        "mem_prompt": nrm(ks[2], (BATCH, N_MEM, D_MODEL), 1.0),
        "cache_swa_k": nrm(ks[3], (DEPTH, DEC_BATCH, swa_len, SWA_KV_HEADS, SWA_HEAD_DIM), 1.0),
        "cache_swa_v": nrm(ks[4], (DEPTH, DEC_BATCH, swa_len, SWA_KV_HEADS, SWA_HEAD_DIM), 1.0),
        "state_ret": nrm(ks[5], (DEPTH, DEC_BATCH, RET_HEADS, RET_QK_DIM, RET_V_DIM), 0.5),
        "state_ffn_conv": nrm(ks[6], (DEPTH, DEC_BATCH, CONV_W - 1, 2 * D_FF), 1.0),
        "cache_mem_k": nrm(ks[7], (DEPTH, DEC_BATCH, N_MEM, MEM_HEADS, MEM_HEAD_DIM), 1.0),
        "cache_mem_v": nrm(ks[8], (DEPTH, DEC_BATCH, N_MEM, MEM_HEADS, MEM_HEAD_DIM), 1.0),
        "g_mix": 1.0 + nrm(ks[9], (DEPTH, D_MODEL), 0.02),
        "w_in": nrm(ks[10], (DEPTH, D_MODEL, IN_COLS), D_MODEL ** -0.5),
        "b_gate": nrm(ks[11], (DEPTH, N_BRANCH * D_MODEL), 0.02),
        "sink": nrm(ks[12], (DEPTH, SWA_HEADS), 0.5),
        "w_br": nrm(ks[13], (DEPTH, MIX_W, D_MODEL), SWA_Q ** -0.5),
        "w_o": nrm(ks[14], (DEPTH, D_MODEL, D_MODEL), D_MODEL ** -0.5),
        "g_mem": 1.0 + nrm(ks[15], (DEPTH, D_MODEL), 0.02),
        "w_mem_kv": nrm(ks[16], (DEPTH, D_MODEL, 2 * MEM_W), D_MODEL ** -0.5),
        "g_ffn": 1.0 + nrm(ks[17], (DEPTH, D_MODEL), 0.02),
        "w_up": nrm(ks[18], (DEPTH, D_MODEL, 2 * D_FF), D_MODEL ** -0.5),
        "w_conv": nrm(ks[19], (DEPTH, CONV_W, 2 * D_FF), CONV_W ** -0.5),
        "b_conv": nrm(ks[20], (DEPTH, 2 * D_FF), 0.02),
        "w_down": nrm(ks[21], (DEPTH, D_FF, D_MODEL), D_FF ** -0.5),
        "g_final": 1.0 + nrm(ks[22], (D_MODEL,), 0.02),
    }


def reference(x_prompt, x_sample, mem_prompt, cache_swa_k, cache_swa_v, state_ret, state_ffn_conv,
              cache_mem_k, cache_mem_v, g_mix, w_in, b_gate, sink, w_br, w_o, g_mem, w_mem_kv,
              g_ffn, w_up, w_conv, b_conv, w_down, g_final):
    Bp, S, _ = x_prompt.shape
    T = x_sample.shape[1]
    pos_p = jnp.arange(S)
    pos_s = PAST_LEN + jnp.arange(T)
    hp, hs = x_prompt, x_sample
    kp_l, vp_l, sp_l, cp_l, mk_l, mv_l = [], [], [], [], [], []
    ks_l, vs_l, ss_l, cs_l = [], [], [], []
    for l in range(DEPTH):
        w = (g_mix[l], w_in[l], b_gate[l], sink[l], w_br[l], w_o[l],
             g_ffn[l], w_up[l], w_conv[l], b_conv[l], w_down[l])
        mk, mv = memory_kv(mem_prompt, g_mem[l], w_mem_kv[l])
        zero_buf = jnp.zeros((Bp, CONV_W - 1, 2 * D_FF), hp.dtype)
        hp, kp, vp, sp, cp = run_layer(hp, pos_p, mk, mv, None, None, zero_buf, *w)
        hs, ksn, vsn, ssn, csn = run_layer(hs, pos_s, cache_mem_k[l], cache_mem_v[l],
                                            (cache_swa_k[l], cache_swa_v[l]), state_ret[l],
                                            state_ffn_conv[l], *w)
        kp_l.append(kp); vp_l.append(vp); sp_l.append(sp); cp_l.append(cp); mk_l.append(mk); mv_l.append(mv)
        ks_l.append(ksn); vs_l.append(vsn); ss_l.append(ssn); cs_l.append(csn)
    y_prompt = rmsnorm(hp, g_final)
    y_sample = rmsnorm(hs, g_final)
    return (y_prompt, y_sample,
            jnp.stack(kp_l), jnp.stack(vp_l), jnp.stack(sp_l), jnp.stack(cp_l),
            jnp.stack(mk_l), jnp.stack(mv_l),
            jnp.stack(ks_l), jnp.stack(vs_l), jnp.stack(ss_l), jnp.stack(cs_l))
```

```cpp
#include <hip/hip_runtime.h>
#include <hip/hip_cooperative_groups.h>
#include <cstdio>
#include <cstdint>
namespace cg = cooperative_groups;

#define DI __device__ __forceinline__
#define LAS __attribute__((address_space(3)))
typedef unsigned short bf16_t;
typedef short bf16x8 __attribute__((ext_vector_type(8)));
typedef short s16x4 __attribute__((ext_vector_type(4)));
typedef float f32x4 __attribute__((ext_vector_type(4)));
typedef float f32x16 __attribute__((ext_vector_type(16)));
typedef unsigned u32x4 __attribute__((ext_vector_type(4)));
typedef unsigned u32x2 __attribute__((ext_vector_type(2)));
typedef float f32x2_t __attribute__((ext_vector_type(2)));
typedef __bf16 bf16x2_t __attribute__((ext_vector_type(2)));

constexpr int MP = 32768, MS = 512, MT = MP + MS;
constexpr int DM = 2048, NIN = 12800, FF = 5632, FF2 = 11264;
constexpr int FFP = 5696;
constexpr float EPS = 1e-6f;
constexpr float LOG2E = 1.4426950408889634f;

constexpr size_t MiB = 1u << 20;
constexpr size_t WS_BAR = 512 * 1024;
constexpr size_t WS_CTL = 0;
constexpr size_t WS_WIN = 1 * MiB;
constexpr size_t WS_WBR = 51 * MiB;
constexpr size_t WS_WO = 63 * MiB;
constexpr size_t WS_WMEM = 71 * MiB;
constexpr size_t WS_WUP = 79 * MiB;
constexpr size_t WS_WDN = 983 * MiB;
constexpr size_t WS_QS = 145 * MiB, WS_QR = 210 * MiB, WS_QM = 275 * MiB, WS_KR = 340 * MiB, WS_VR = 405 * MiB, WS_GR = 470 * MiB;
constexpr size_t WS_KS = 535 * MiB, WS_VS = WS_KS + (size_t)MT * 256 * 2;
constexpr size_t WS_GT = WS_VS + (size_t)MT * 256 * 2;
constexpr size_t WS_MK = WS_GT + (size_t)MT * 6144 * 2, WS_MV = WS_MK + 6 * MiB;
constexpr size_t WS_MEMN = WS_MV + 6 * MiB;
constexpr size_t WS_S0T = WS_MEMN + 4 * MiB;
constexpr size_t WS_MS32 = WS_S0T + 2 * MiB;
constexpr size_t WS_END = WS_MS32 + 4 * MiB;
constexpr size_t WS_MERGED = WS_KR;
constexpr size_t WS_H1B = WS_QS;
constexpr size_t WS_ACT = WS_GT;
constexpr size_t WS_RAW = WS_QM;
static_assert(WS_END <= 983 * MiB && WS_WDN + (size_t)2048 * 5696 * 2 <= 1024 * MiB, "ws map");
static_assert(WS_RAW + (size_t)128 * 4 * 4 * 2 * FF * 4 <= WS_VR, "raw rows");

constexpr size_t O_Y = 0;
constexpr size_t O_SWAK_P = (size_t)MT * DM, O_SWAV_P = O_SWAK_P + 131072, O_RET_P = O_SWAV_P + 131072, O_CONV_P = O_RET_P + 524288,
                 O_MEMK = O_CONV_P + 90112, O_MEMV = O_MEMK + 1048576, O_SWAK_S = O_MEMV + 1048576, O_SWAV_S = O_SWAK_S + 262144,
                 O_RET_S = O_SWAV_S + 262144, O_CONV_S = O_RET_S + 1048576, O_END = O_CONV_S + 180224;

struct Args {
    const float* in[23]; float* out; unsigned char* ws; int ph_lo, ph_hi;
};

struct Ctx {
    const float *xp, *xs, *memp, *cswak, *cswav, *sret, *sconv, *cmemk, *cmemv, *g_mix, *w_in, *b_gate, *sink, *w_br, *w_o, *g_mem, *w_mem, *g_ffn, *w_up, *w_conv, *b_conv, *w_down, *g_final;
    float* out; unsigned char* ws;
};

DI int lane_id() { int l; asm volatile("v_mbcnt_lo_u32_b32 %0, -1, 0\n\tv_mbcnt_hi_u32_b32 %0, -1, %0" : "=v"(l)); return l; }
DI unsigned cvtpk(float lo, float hi) { f32x2_t v = {lo, hi}; bf16x2_t b = __builtin_convertvector(v, bf16x2_t); return __builtin_bit_cast(unsigned, b); }
DI float bf2f(unsigned short h) { return __uint_as_float((unsigned)h << 16); }
DI float bflo(unsigned w) { return __uint_as_float(w << 16); }
DI float bfhi(unsigned w) { return __uint_as_float(w & 0xffff0000u); }
DI float fexp2(float x) { return __builtin_amdgcn_exp2f(x); }
DI float frcp(float x) { return __builtin_amdgcn_rcpf(x); }
DI float silu_f(float x) { return x * frcp(1.f + fexp2(-x * LOG2E)); }
DI float sigm_f(float x) { return frcp(1.f + fexp2(-x * LOG2E)); }
DI float wave_sum(float v) {
#pragma unroll
    for (int o = 1; o < 64; o <<= 1) v += __shfl_xor(v, o);
    return v;
}
DI float log2gamma(int h) { const float x = fexp2(-5.f - (float)h); return -x * (1.f + x * (0.5f + x * (0.33333334f + x * (0.25f + x * (0.2f + x * 0.16666667f))))) * LOG2E; }

namespace pg8 {
constexpr int BM = 256, BK = 64, HALF = 128, HTB = HALF * BK * 2, STAGE_BYTES = 8 * HTB, NXCD = 8, WGM = 8;
DI int lds_byte(int r, int c) { const int st = (r >> 4) * 2 + (c >> 5), rr = r & 15, cc = c & 31, ob = rr * 64 + cc * 2; return st * 1024 + (ob ^ (((ob >> 9) & 1) << 5)); }
DI void stage_rc(int b, int& R, int& C) { const int st = b / 1024, sb = b % 1024, swz = sb ^ (((sb >> 9) & 1) << 5); R = (st >> 1) * 16 + swz / 64; C = (st & 1) * 32 + (swz % 64) / 2; }
DI int perm32(int rho) { const int n = rho >> 4, i = rho & 15; return 8 * (i >> 2) + 4 * n + (i & 3); }
struct Unit { int pm, pn, z, nt, kp; };
DI void tile_map(int L, int nM, int nN, int& pm, int& pn) {
    const int nwg = nM * nN; int wgid = L;
    { const int q = nwg / NXCD, r = nwg % NXCD, xcd = wgid % NXCD, off = wgid / NXCD; wgid = (xcd < r ? xcd * (q + 1) : r * (q + 1) + (xcd - r) * q) + off; }
    const int nig = WGM * nN, gid = wgid / nig, fm = gid * WGM, gsz = (nM - fm) < WGM ? (nM - fm) : WGM;
    pm = fm + ((wgid % nig) % gsz); pn = (wgid % nig) / gsz;
}
template <class Epi, class Sched>
DI void gemm_phase(LAS unsigned char* lds, const int K, const Sched& S, const Epi& E, const int wid) {
    const int lane = lane_id(), tid = wid * 64 + lane, wr = wid >> 2, wc = wid & 3, fr = lane & 15, fq = lane >> 4;
    unsigned voffA[2], voffB[2];
#pragma unroll
    for (int i = 0; i < 2; ++i) { int R, C; stage_rc(tid * 16 + i * 8192, R, C); const int Rb = (R & ~31) + perm32(R & 31);
        voffA[i] = (unsigned)(R * K + C) * 2u; voffB[i] = (unsigned)(Rb * K + C) * 2u; }
    const size_t kstep = (size_t)(BK * 2);
    const size_t hstep = (size_t)HALF * K * 2;
    const unsigned ldsw = (unsigned)wid * 1024u;
    const int aoff = lds_byte(wr * 64 + fr, fq * 8), boff = lds_byte(wc * 32 + fr, fq * 8);
#define PG8_SA(b, h) (((b) * 2 + (h)) * HTB)
#define PG8_SB(b, h) ((4 + (b) * 2 + (h)) * HTB)
#define PG8_STAGE(bufoff, gbase, voff) do { _Pragma("unroll") for (int _i = 0; _i < 2; ++_i) \
        __builtin_amdgcn_global_load_lds((const unsigned*)((const char*)(gbase) + (voff)[_i]), (LAS unsigned*)(lds + (bufoff) + ldsw + _i * 8192), 16, 0, 0); } while (0)
#define PG8_LDA(dst, b, h) do { _Pragma("unroll") for (int m = 0; m < 4; ++m) _Pragma("unroll") for (int k = 0; k < 2; ++k) dst[m][k] = *(const LAS bf16x8*)(lds + PG8_SA(b, h) + aoff + m * 2048 + k * 1024); } while (0)
#define PG8_LDB(dst, b, h) do { _Pragma("unroll") for (int n = 0; n < 2; ++n) _Pragma("unroll") for (int k = 0; k < 2; ++k) dst[n][k] = *(const LAS bf16x8*)(lds + PG8_SB(b, h) + boff + n * 2048 + k * 1024); } while (0)
#define PG8_MMA(ai, bj, At, Bt) do { __builtin_amdgcn_s_setprio(1); _Pragma("unroll") for (int m = 0; m < 4; ++m) _Pragma("unroll") for (int n = 0; n < 2; ++n) _Pragma("unroll") for (int k = 0; k < 2; ++k) \
        acc[ai][bj][m][n] = __builtin_amdgcn_mfma_f32_16x16x32_bf16(Bt[n][k], At[m][k], acc[ai][bj][m][n], 0, 0, 0); __builtin_amdgcn_s_setprio(0); } while (0)
#define PG8_WAIT_V(n) asm volatile("s_waitcnt vmcnt(" #n ")" ::: "memory")
#define PG8_WAIT_L(n) asm volatile("s_waitcnt lgkmcnt(" #n ")" ::: "memory")
#define PG8_BAR __builtin_amdgcn_s_barrier()
#define PG8_SCHED __builtin_amdgcn_sched_barrier(0)
    Unit cur, nxt; int ui = 0;
    if (!S.next(0, cur)) return;
    f32x4 acc[2][2][4][2];
#pragma unroll
    for (int a = 0; a < 2; ++a)
#pragma unroll
        for (int b = 0; b < 2; ++b)
#pragma unroll
            for (int m = 0; m < 4; ++m)
#pragma unroll
                for (int n = 0; n < 2; ++n) acc[a][b][m][n] = (f32x4){0.f, 0.f, 0.f, 0.f};
    bf16x8 At[4][2], B0[2][2], B1[2][2];
    S.a_ready(cur);
    const char* cA = S.aptr(cur); const char* cB = S.bptr(cur);
    PG8_STAGE(PG8_SB(0, 0), cB, voffB); PG8_STAGE(PG8_SB(0, 1), cB + hstep, voffB); PG8_STAGE(PG8_SA(0, 0), cA, voffA); PG8_STAGE(PG8_SA(0, 1), cA + hstep, voffA);
    if (wr == 1) PG8_BAR;
    PG8_WAIT_V(2); PG8_BAR;
    PG8_STAGE(PG8_SB(1, 0), cB + kstep, voffB); PG8_STAGE(PG8_SA(1, 0), cA + kstep, voffA); PG8_STAGE(PG8_SB(1, 1), cB + hstep + kstep, voffB);
    PG8_WAIT_V(6); PG8_BAR;
    for (;;) {
        const bool has_next = S.next(ui + 1, nxt);
        const int nt = cur.nt;
        const char* nA = has_next ? S.aptr(nxt) : cA; const char* nB = has_next ? S.bptr(nxt) : cB;
        for (int t = 0; t < nt; t += 2) {
            const bool last = (t == nt - 2);
            const char* a1 = cA + (size_t)(t + 1) * kstep;
            const char* a2 = last ? nA : cA + (size_t)(t + 2) * kstep; const char* b2 = last ? nB : cB + (size_t)(t + 2) * kstep;
            const char* a3 = a2 + kstep; const char* b3 = b2 + kstep;
            if (last && has_next) S.a_ready(nxt);
            PG8_LDB(B0, 0, 0); PG8_LDB(B1, 0, 1); PG8_SCHED; PG8_LDA(At, 0, 0); PG8_STAGE(PG8_SA(1, 1), a1 + hstep, voffA);
            PG8_WAIT_V(8); PG8_WAIT_L(0); PG8_BAR; PG8_MMA(0, 0, At, B0); PG8_MMA(0, 1, At, B1); PG8_BAR; PG8_SCHED;
            PG8_LDA(At, 0, 1); PG8_STAGE(PG8_SB(0, 0), b2, voffB); PG8_STAGE(PG8_SB(0, 1), b2 + hstep, voffB); PG8_STAGE(PG8_SA(0, 0), a2, voffA);
            PG8_WAIT_V(8); PG8_WAIT_L(0); PG8_BAR; PG8_MMA(1, 0, At, B0); PG8_MMA(1, 1, At, B1); PG8_BAR; PG8_SCHED;
            PG8_LDB(B0, 1, 0); PG8_LDB(B1, 1, 1); PG8_SCHED; PG8_LDA(At, 1, 0); PG8_STAGE(PG8_SA(0, 1), a2 + hstep, voffA);
            PG8_WAIT_V(8); PG8_WAIT_L(0); PG8_BAR; PG8_MMA(0, 0, At, B0); PG8_MMA(0, 1, At, B1); PG8_BAR; PG8_SCHED;
            PG8_LDA(At, 1, 1); PG8_STAGE(PG8_SB(1, 0), b3, voffB); PG8_STAGE(PG8_SB(1, 1), b3 + hstep, voffB); PG8_STAGE(PG8_SA(1, 0), a3, voffA);
            PG8_WAIT_V(8); PG8_WAIT_L(0); PG8_BAR; PG8_MMA(1, 0, At, B0); PG8_MMA(1, 1, At, B1); PG8_BAR; PG8_SCHED;
        }
        if (wr == 0) PG8_BAR;
        E(acc, cur, wr, wc, fr, fq);
        if (!has_next) break;
#pragma unroll
        for (int a = 0; a < 2; ++a)
#pragma unroll
            for (int b = 0; b < 2; ++b)
#pragma unroll
                for (int m = 0; m < 4; ++m)
#pragma unroll
                    for (int n = 0; n < 2; ++n) acc[a][b][m][n] = (f32x4){0.f, 0.f, 0.f, 0.f};
        cur = nxt; cA = nA; cB = nB; ++ui;
        if (wr == 1) PG8_BAR;
    }
    PG8_WAIT_V(0);
    PG8_BAR;
#undef PG8_SA
#undef PG8_SB
#undef PG8_STAGE
#undef PG8_LDA
#undef PG8_LDB
#undef PG8_MMA
#undef PG8_WAIT_V
#undef PG8_WAIT_L
#undef PG8_BAR
#undef PG8_SCHED
}
}
using pg8::Unit;
typedef f32x4 Acc[2][2][4][2];

DI void store8bf(bf16_t* p, f32x4 a, f32x4 b) { u32x4 w; w.x = cvtpk(a[0], a[1]); w.y = cvtpk(a[2], a[3]); w.z = cvtpk(b[0], b[1]); w.w = cvtpk(b[2], b[3]); *(u32x4*)p = w; }

DI void wait_counter(const unsigned* ctr, unsigned target) {
    while (__hip_atomic_load(ctr, __ATOMIC_RELAXED, __HIP_MEMORY_SCOPE_AGENT) < target) __builtin_amdgcn_s_sleep(2);
    __builtin_amdgcn_fence(__ATOMIC_ACQUIRE, "agent");
}
struct SchedSimple {
    const char *A, *B; int nM, nN, G, c; size_t tstep; int ntk; const unsigned* ctr; unsigned target;
    DI bool next(int i, Unit& u) const { const long L = (long)i * G + c; if (L >= (long)nM * nN) return false; pg8::tile_map((int)L, nM, nN, u.pm, u.pn); u.z = 0; u.nt = ntk; u.kp = -1; return true; }
    DI const char* aptr(const Unit& u) const { return A + (size_t)u.pm * tstep; }
    DI const char* bptr(const Unit& u) const { return B + (size_t)u.pn * tstep; }
    DI void a_ready(const Unit& u) const { if (ctr && u.pm >= 128) wait_counter(ctr, target); }
};
struct SchedP1 {
    const char *A, *B, *A2, *B2; int G, c;
    DI bool next(int i, Unit& u) const { long L = (long)i * G + c; u.nt = 32; u.kp = -1; if (L < 130 * 50) { pg8::tile_map((int)L, 130, 50, u.pm, u.pn); u.z = 0; return true; }
        L -= 130 * 50; if (L < 32) { u.pm = (int)(L >> 3); u.pn = (int)(L & 7); u.z = 1; return true; } return false; }
    DI const char* aptr(const Unit& u) const { return (u.z ? A2 : A) + (size_t)u.pm * (256 * 2048 * 2); }
    DI const char* bptr(const Unit& u) const { return (u.z ? B2 : B) + (size_t)u.pn * (256 * 2048 * 2); }
    DI void a_ready(const Unit&) const {}
};
template <int NP>
struct SchedSplit {
    const char *A, *B; int G, c; int K; const unsigned* ctr; unsigned target; int pitch;
    DI bool next(int i, Unit& u) const {
        const int L = i * G + c; int pm, pn, nt, kp; bool ok = true;
        if (L < 1024) { pg8::tile_map(L, 128, 8, pm, pn); nt = K / 64; kp = -1; }
        else { const int P = L - 1024, tile = P / NP; kp = P % NP; pm = 128 + (tile >> 3); pn = tile & 7; nt = 8; ok = P < 16 * NP; }
        u.pm = pm; u.pn = pn; u.z = 0; u.nt = nt; u.kp = kp; return ok; }
    DI const char* aptr(const Unit& u) const { return A + ((size_t)u.pm * 256 * pitch + (u.kp > 0 ? u.kp * 512 : 0)) * 2; }
    DI const char* bptr(const Unit& u) const { return B + ((size_t)u.pn * 256 * pitch + (u.kp > 0 ? u.kp * 512 : 0)) * 2; }
    DI void a_ready(const Unit& u) const { if (ctr && u.pm >= 128) wait_counter(ctr, target); }
};
struct SchedMerge {
    const char *A0, *A1, *A2, *B; int G, c;
    DI bool next(int i, Unit& u) const {
        int pm, pn, z, nt, kp; bool ok = true;
        if (i < 12) { pg8::tile_map((i / 3) * 256 + c, 128, 8, pm, pn); z = i % 3; nt = 16; kp = -1; }
        else { const int L = (i - 12) * 256 + c, tile = L / 6, rem = L % 6; pm = 128 + (tile >> 3); pn = tile & 7; z = rem >> 1; kp = rem & 1; nt = 8; ok = L < 96; }
        u.pm = pm; u.pn = pn; u.z = z; u.nt = nt; u.kp = kp; return ok; }
    DI const char* aptr(const Unit& u) const { return (u.z == 0 ? A0 : (u.z == 1 ? A1 : A2)) + ((size_t)u.pm * 256 * 1024 + (u.kp > 0 ? 512 : 0)) * 2; }
    DI const char* bptr(const Unit& u) const { return B + (((size_t)u.z * 2048 + (size_t)u.pn * 256) * 1024 + (u.kp > 0 ? 512 : 0)) * 2; }
    DI void a_ready(const Unit&) const {}
};

struct EpiP1 {
    bf16_t *QS, *KS, *VS, *QR, *KR, *VR, *GR, *QM, *GT, *MK, *MV; const float* b_gate; float* out;
    DI void plain(const Acc& acc, bf16_t* O, int ld, int col0, int row0, float sc, int act) const {
#pragma unroll
        for (int ai = 0; ai < 2; ++ai)
#pragma unroll
            for (int m = 0; m < 4; ++m) { bf16_t* rowp = O + (size_t)(row0 + ai * 128 + m * 16) * ld + col0;
#pragma unroll
                for (int bj = 0; bj < 2; ++bj) { f32x4 v0 = acc[ai][bj][m][0] * sc, v1 = acc[ai][bj][m][1] * sc;
                    if (act == 1) {
#pragma unroll
                        for (int j = 0; j < 4; ++j) { v0[j] = silu_f(v0[j]); v1[j] = silu_f(v1[j]); } }
                    store8bf(rowp + bj * 128, v0, v1); } }
    }
    DI void operator()(const Acc& acc, const Unit& u, int wr, int wc, int fr, int fq) const {
        asm volatile("" : "+v"(fr), "+v"(fq));
        const int row0 = u.pm * 256 + wr * 64 + fr, cl = wc * 32 + 8 * fq;
        if (u.z == 1) {
            bf16_t* Ob = (u.pn < 4) ? MK : MV; float* Of = out + ((u.pn < 4) ? O_MEMK : O_MEMV); const int c0 = (u.pn & 3) * 256 + cl;
#pragma unroll
            for (int ai = 0; ai < 2; ++ai)
#pragma unroll
                for (int m = 0; m < 4; ++m) { const size_t r = (size_t)(row0 + ai * 128 + m * 16);
#pragma unroll
                    for (int bj = 0; bj < 2; ++bj) { store8bf(Ob + r * 1024 + c0 + bj * 128, acc[ai][bj][m][0], acc[ai][bj][m][1]);
                        *(f32x4*)(Of + r * 1024 + c0 + bj * 128) = acc[ai][bj][m][0]; *(f32x4*)(Of + r * 1024 + c0 + bj * 128 + 4) = acc[ai][bj][m][1]; } }
            return;
        }
        const int pn = u.pn;
        if (pn < 4) { plain(acc, QS, 1024, pn * 256 + cl, row0, 0.125f * LOG2E, 0); return; }
        if (pn < 6) {
            bf16_t* O = (pn == 4) ? KS : VS; plain(acc, O, 256, cl, row0, 1.f, 0);
            if (u.pm >= 128) {
                float* Of = out + ((pn == 4) ? O_SWAK_S : O_SWAV_S);
#pragma unroll
                for (int ai = 0; ai < 2; ++ai) { const int b = (u.pm - 128) * 4 + 2 * ai + wr;
#pragma unroll
                    for (int m = 0; m < 4; ++m) { float* rp = Of + ((size_t)b * 128 + 64 + 16 * m + fr) * 256 + cl;
#pragma unroll
                        for (int bj = 0; bj < 2; ++bj) { *(f32x4*)(rp + bj * 128) = acc[ai][bj][m][0]; *(f32x4*)(rp + bj * 128 + 4) = acc[ai][bj][m][1]; } } }
            } else if ((u.pm & 31) == 31) {
                float* Of = out + ((pn == 4) ? O_SWAK_P : O_SWAV_P); const int b = u.pm >> 5;
#pragma unroll
                for (int m = 0; m < 4; ++m) { float* rp = Of + ((size_t)b * 128 + 64 * wr + 16 * m + fr) * 256 + cl;
#pragma unroll
                    for (int bj = 0; bj < 2; ++bj) { *(f32x4*)(rp + bj * 128) = acc[1][bj][m][0]; *(f32x4*)(rp + bj * 128 + 4) = acc[1][bj][m][1]; } }
            }
            return;
        }
        if (pn < 14) {
            const bool isq = pn < 10; bf16_t* O = isq ? QR : KR; const int hb = 2 * (pn - (isq ? 6 : 10));
            const int i0 = 16 * wc + 4 * fq; float invf[4];
#pragma unroll
            for (int j = 0; j < 4; ++j) invf[j] = fexp2(-(float)(i0 + j) * (13.287712379549449f / 63.0f));
            const float lg0 = log2gamma(hb), lg1 = log2gamma(hb + 1);
#pragma unroll
            for (int ai = 0; ai < 2; ++ai)
#pragma unroll
                for (int m = 0; m < 4; ++m) {
                    const int row = row0 + ai * 128 + m * 16; const int nl = 16 * m + fr;
                    const float pos = (u.pm >= 128) ? (float)(1024 + nl) : (float)(row & 8191);
                    float cs[4], sn[4];
#pragma unroll
                    for (int j = 0; j < 4; ++j) { float rev = (pos * invf[j]) * 0.15915494309189535f; rev = rev - floorf(rev); cs[j] = __builtin_amdgcn_cosf(rev); sn[j] = __builtin_amdgcn_sinf(rev); }
#pragma unroll
                    for (int bj = 0; bj < 2; ++bj) {
                        const float e = (float)(nl + 1) * (bj ? lg1 : lg0);
                        const float sc = isq ? fexp2(e) : 0.08838834764831845f * fexp2(-e);
                        const f32x4 x1 = acc[ai][bj][m][0], x2 = acc[ai][bj][m][1]; f32x4 o1, o2;
#pragma unroll
                        for (int j = 0; j < 4; ++j) { o1[j] = (x1[j] * cs[j] - x2[j] * sn[j]) * sc; o2[j] = (x1[j] * sn[j] + x2[j] * cs[j]) * sc; }
                        store8bf(O + (size_t)row * 1024 + (hb + bj) * 128 + cl, o1, o2);
                    }
                }
            return;
        }
        if (pn < 18) { plain(acc, VR, 1024, (pn - 14) * 256 + cl, row0, 1.f, 0); return; }
        if (pn < 22) { plain(acc, GR, 1024, (pn - 18) * 256 + cl, row0, 1.f, 1); return; }
        if (pn < 26) { plain(acc, QM, 1024, (pn - 22) * 256 + cl, row0, 0.0625f * LOG2E, 0); return; }
        {
            const int c0 = (pn - 26) * 256 + cl; f32x4 bv[2][2];
#pragma unroll
            for (int bj = 0; bj < 2; ++bj)
#pragma unroll
                for (int n = 0; n < 2; ++n) bv[bj][n] = *(const f32x4*)(b_gate + c0 + bj * 128 + 4 * n);
#pragma unroll
            for (int ai = 0; ai < 2; ++ai)
#pragma unroll
                for (int m = 0; m < 4; ++m) {
                    u32x4 qw;
#pragma unroll
                    for (int bj = 0; bj < 2; ++bj) { f32x4 v0 = acc[ai][bj][m][0] + bv[bj][0], v1 = acc[ai][bj][m][1] + bv[bj][1];
#pragma unroll
                        for (int j = 0; j < 4; ++j) { v0[j] = sigm_f(v0[j]); v1[j] = sigm_f(v1[j]); }
                        const unsigned lo = (unsigned)(v0[0] * 255.f + 0.5f) | ((unsigned)(v0[1] * 255.f + 0.5f) << 8) | ((unsigned)(v0[2] * 255.f + 0.5f) << 16) | ((unsigned)(v0[3] * 255.f + 0.5f) << 24);
                        const unsigned hi = (unsigned)(v1[0] * 255.f + 0.5f) | ((unsigned)(v1[1] * 255.f + 0.5f) << 8) | ((unsigned)(v1[2] * 255.f + 0.5f) << 16) | ((unsigned)(v1[3] * 255.f + 0.5f) << 24);
                        if (bj == 0) { qw.x = lo; qw.y = hi; } else { qw.z = lo; qw.w = hi; } }
                    *(u32x4*)((unsigned char*)GT + ((size_t)u.pm * 24 + (pn - 26)) * 65536 + ((size_t)(((wr * 4 + wc) * 8 + ai * 4 + m) * 64 + fq * 16 + fr)) * 16) = qw; }
        }
    }
};

DI float gq(unsigned w, int j) { return (float)((w >> (8 * j)) & 255u) * (1.0f / 255.0f); }
struct EpiMerge {
    const bf16_t* GT; bf16_t* MG; float* MS32; bf16_t* T;
    DI void operator()(const Acc& acc, const Unit& u, int wr, int wc, int fr, int fq) const {
        asm volatile("" : "+v"(fr), "+v"(fq));
        const int row0 = u.pm * 256 + wr * 64 + fr, c0 = u.pn * 256 + wc * 32 + 8 * fq;
        bf16_t* Tp = T + ((size_t)((wr * 4 + wc) * 16) * 64 + fq * 16 + fr) * 8;
        if (u.kp >= 0) {
            float* P = MS32 + (size_t)(u.z * 2 + u.kp) * MS * DM;
#pragma unroll
            for (int ai = 0; ai < 2; ++ai) {
                u32x2 g[4][2];
#pragma unroll
                for (int m = 0; m < 4; ++m) { const u32x4 gw = *(const u32x4*)((const unsigned char*)GT + ((size_t)u.pm * 24 + u.z * 8 + u.pn) * 65536 + ((size_t)(((wr * 4 + wc) * 8 + ai * 4 + m) * 64 + fq * 16 + fr)) * 16); g[m][0] = (u32x2){gw.x, gw.y}; g[m][1] = (u32x2){gw.z, gw.w}; }
#pragma unroll
                for (int m = 0; m < 4; ++m)
#pragma unroll
                    for (int bj = 0; bj < 2; ++bj) { const u32x2 gg = g[m][bj]; float* d = P + (size_t)(row0 - MP + ai * 128 + m * 16) * 2048 + c0 + bj * 128;
                        f32x4 v0 = acc[ai][bj][m][0], v1 = acc[ai][bj][m][1];
                        v0[0] *= gq(gg.x, 0); v0[1] *= gq(gg.x, 1); v0[2] *= gq(gg.x, 2); v0[3] *= gq(gg.x, 3); v1[0] *= gq(gg.y, 0); v1[1] *= gq(gg.y, 1); v1[2] *= gq(gg.y, 2); v1[3] *= gq(gg.y, 3);
                        *(f32x4*)d = v0; *(f32x4*)(d + 4) = v1; }
                asm volatile("" ::: "memory");
            }
            return;
        }
#pragma unroll
        for (int ai = 0; ai < 2; ++ai) {
            u32x2 g[4][2]; u32x4 p[4][2];
#pragma unroll
            for (int m = 0; m < 4; ++m) { const u32x4 gw = *(const u32x4*)((const unsigned char*)GT + ((size_t)u.pm * 24 + u.z * 8 + u.pn) * 65536 + ((size_t)(((wr * 4 + wc) * 8 + ai * 4 + m) * 64 + fq * 16 + fr)) * 16); g[m][0] = (u32x2){gw.x, gw.y}; g[m][1] = (u32x2){gw.z, gw.w}; }
            if (u.z > 0) {
#pragma unroll
                for (int m = 0; m < 4; ++m)
#pragma unroll
                    for (int bj = 0; bj < 2; ++bj) p[m][bj] = *(const u32x4*)(Tp + (size_t)(ai * 8 + m * 2 + bj) * 512);
            } else {
#pragma unroll
                for (int m = 0; m < 4; ++m)
#pragma unroll
                    for (int bj = 0; bj < 2; ++bj) p[m][bj] = (u32x4){0u, 0u, 0u, 0u};
            }
#pragma unroll
            for (int m = 0; m < 4; ++m)
#pragma unroll
                for (int bj = 0; bj < 2; ++bj) {
                    const u32x2 gg = g[m][bj]; const u32x4 pp = p[m][bj];
                    f32x4 v0 = acc[ai][bj][m][0], v1 = acc[ai][bj][m][1];
                    v0[0] = v0[0] * gq(gg.x, 0) + bflo(pp.x); v0[1] = v0[1] * gq(gg.x, 1) + bfhi(pp.x); v0[2] = v0[2] * gq(gg.x, 2) + bflo(pp.y); v0[3] = v0[3] * gq(gg.x, 3) + bfhi(pp.y);
                    v1[0] = v1[0] * gq(gg.y, 0) + bflo(pp.z); v1[1] = v1[1] * gq(gg.y, 1) + bfhi(pp.z); v1[2] = v1[2] * gq(gg.y, 2) + bflo(pp.w); v1[3] = v1[3] * gq(gg.y, 3) + bfhi(pp.w);
                    if (u.z < 2) store8bf(Tp + (size_t)(ai * 8 + m * 2 + bj) * 512, v0, v1);
                    else store8bf(MG + (size_t)(row0 + ai * 128 + m * 16) * 2048 + c0 + bj * 128, v0, v1);
                }
            asm volatile("" ::: "memory");
        }
    }
};

DI void partial_tile(const Acc& acc, float* P, int rows0, int c0) {
#pragma unroll
    for (int ai = 0; ai < 2; ++ai)
#pragma unroll
        for (int m = 0; m < 4; ++m)
#pragma unroll
            for (int bj = 0; bj < 2; ++bj) { float* d = P + (size_t)(rows0 + ai * 128 + m * 16) * DM + c0 + bj * 128; *(f32x4*)d = acc[ai][bj][m][0]; *(f32x4*)(d + 4) = acc[ai][bj][m][1]; }
}
struct EpiWo {
    const float* xp; float* PART; bf16_t* H1B; float* ss1;
    DI void operator()(const Acc& acc, const Unit& u, int wr, int wc, int fr, int fq) const {
        const int row0 = u.pm * 256 + wr * 64 + fr, c0 = u.pn * 256 + wc * 32 + 8 * fq;
        if (u.kp >= 0) { partial_tile(acc, PART + (size_t)u.kp * MS * DM, row0 - MP, c0); return; }
#pragma unroll
        for (int ai = 0; ai < 2; ++ai) {
            f32x4 xv[4][2][2];
#pragma unroll
            for (int m = 0; m < 4; ++m)
#pragma unroll
                for (int bj = 0; bj < 2; ++bj) { const size_t o = (size_t)(row0 + ai * 128 + m * 16) * DM + c0 + bj * 128; xv[m][bj][0] = *(const f32x4*)(xp + o); xv[m][bj][1] = *(const f32x4*)(xp + o + 4); }
#pragma unroll
            for (int m = 0; m < 4; ++m) { const size_t r = (size_t)(row0 + ai * 128 + m * 16); float s = 0.f;
#pragma unroll
                for (int bj = 0; bj < 2; ++bj) { const size_t o = r * DM + c0 + bj * 128;
                    const f32x4 v0 = acc[ai][bj][m][0] + xv[m][bj][0], v1 = acc[ai][bj][m][1] + xv[m][bj][1];
                    store8bf(H1B + o, v0, v1);
                    s += (v0[0] * v0[0] + v0[1] * v0[1]) + (v0[2] * v0[2] + v0[3] * v0[3]) + (v1[0] * v1[0] + v1[1] * v1[1]) + (v1[2] * v1[2] + v1[3] * v1[3]); }
                s += __shfl_xor(s, 16); s += __shfl_xor(s, 32);
                if (fq == 0) atomicAdd(ss1 + r, s); }
            asm volatile("" ::: "memory");
        }
    }
};

struct EpiDown {
    float* PART; bf16_t* H1B;
    DI void operator()(const Acc& acc, const Unit& u, int wr, int wc, int fr, int fq) const {
        const int row0 = u.pm * 256 + wr * 64 + fr, c0 = u.pn * 256 + wc * 32 + 8 * fq;
        if (u.kp >= 0) { partial_tile(acc, PART + (size_t)u.kp * MS * DM, row0 - MP, c0); return; }
#pragma unroll
        for (int ai = 0; ai < 2; ++ai) {
            u32x4 hv[4][2];
#pragma unroll
            for (int m = 0; m < 4; ++m)
#pragma unroll
                for (int bj = 0; bj < 2; ++bj) hv[m][bj] = *(const u32x4*)(H1B + (size_t)(row0 + ai * 128 + m * 16) * DM + c0 + bj * 128);
#pragma unroll
            for (int m = 0; m < 4; ++m)
#pragma unroll
                for (int bj = 0; bj < 2; ++bj) { const u32x4 h = hv[m][bj]; f32x4 v0 = acc[ai][bj][m][0], v1 = acc[ai][bj][m][1];
                    v0[0] += bflo(h.x); v0[1] += bfhi(h.x); v0[2] += bflo(h.y); v0[3] += bfhi(h.y); v1[0] += bflo(h.z); v1[1] += bfhi(h.z); v1[2] += bflo(h.w); v1[3] += bfhi(h.w);
                    store8bf(H1B + (size_t)(row0 + ai * 128 + m * 16) * DM + c0 + bj * 128, v0, v1); }
            asm volatile("" ::: "memory");
        }
    }
};

template <int CTRL> DI float dpp_ror(float v) { return __builtin_bit_cast(float, __builtin_amdgcn_update_dpp(0, __builtin_bit_cast(int, v), CTRL, 0xf, 0xf, false)); }

struct EpiUp {
    const float *ss1, *w_conv, *b_conv, *sconv; bf16_t* ACT; float* RAW; float* out; LAS unsigned char* xl;
    template <int GV>
    DI void conv_cols(const Acc& acc, const Unit& u, int ai, int n, int G, int f, int fr, const float (&rs)[4], bool samp, int sb, const f32x4 (&cw)[4], f32x4 (&cg)[4], bf16_t* actp) const {
        f32x4 X[4];
#pragma unroll
        for (int m = 0; m < 4; ++m) X[m] = acc[ai][GV][m][n] * rs[m];
        f32x4 Hh = (f32x4){0.f, 0.f, 0.f, 0.f};
        if (samp) { if (fr >= 14) Hh = *(const f32x4*)(sconv + ((size_t)sb * 2 + (fr - 14)) * FF2 + GV * FF + f); }
        else {
            float* rw = RAW + ((((size_t)u.pm * 4 + G) * 4) * 2 + GV) * FF + f;
            if (fr < 2 || fr >= 14) *(f32x4*)(rw + (size_t)(fr < 2 ? fr : fr - 12) * 2 * FF) = (fr < 2) ? X[0] : X[3];
        }
        if (fr >= 14) {
            if (samp) *(f32x4*)(out + O_CONV_S + ((size_t)sb * 2 + (fr - 14)) * FF2 + GV * FF + f) = X[3];
            else if ((u.pm & 31) == 31 && G == 3) *(f32x4*)(out + O_CONV_P + ((size_t)(u.pm >> 5) * 2 + (fr - 14)) * FF2 + GV * FF + f) = X[3];
        }
#pragma unroll
        for (int m = 0; m < 4; ++m) {
            f32x4 p1, p2;
#pragma unroll
            for (int j = 0; j < 4; ++j) {
                const float prev = (m == 0) ? Hh[j] : X[m - 1][j];
                const float a1 = dpp_ror<0x121>(X[m][j]), b1 = dpp_ror<0x121>(prev);
                const float a2 = dpp_ror<0x122>(X[m][j]), b2 = dpp_ror<0x122>(prev);
                p1[j] = (fr >= 1) ? a1 : b1; p2[j] = (fr >= 2) ? a2 : b2;
            }
            const f32x4 c = cw[3] + cw[0] * p2 + cw[1] * p1 + cw[2] * X[m];
            if (GV == 0) cg[m] = c;
            else { u32x2 wv; wv.x = cvtpk(silu_f(cg[m][0]) * c[0], silu_f(cg[m][1]) * c[1]); wv.y = cvtpk(silu_f(cg[m][2]) * c[2], silu_f(cg[m][3]) * c[3]);
                *(u32x2*)(actp + (size_t)(m * 16) * FFP) = wv; }
        }
    }
    DI void operator()(const Acc& acc, const Unit& u, int wr, int wc, int fr, int fq) const {
        asm volatile("" : "+v"(fr), "+v"(fq));
        const int row0 = u.pm * 256 + wr * 64 + fr; const int f0 = u.pn * 128 + wc * 32 + 8 * fq; const bool samp = u.pm >= 128;
        {
            const int t = (wr * 4 + wc) * 64 + fq * 16 + fr;
            LAS float* cwl = (LAS float*)xl; LAS float* ssl = cwl + 1024;
            if (t < 256) { const int q = t >> 5, f4 = (t & 31) * 4, gv = q >> 2, tap = q & 3;
                *(LAS f32x4*)(cwl + q * 128 + f4) = *(const f32x4*)((tap < 3 ? w_conv + (size_t)tap * FF2 : b_conv) + gv * FF + u.pn * 128 + f4); }
            else if (t < 320) *(LAS f32x4*)(ssl + (t - 256) * 4) = *(const f32x4*)(ss1 + (size_t)u.pm * 256 + (t - 256) * 4);
            asm volatile("s_waitcnt lgkmcnt(0)" ::: "memory");
            __builtin_amdgcn_s_barrier();
            asm volatile("" ::: "memory");
        }
        const LAS float* cwl = (const LAS float*)xl; const LAS float* ssl = cwl + 1024;
        float rs[2][4];
#pragma unroll
        for (int ai = 0; ai < 2; ++ai)
#pragma unroll
            for (int m = 0; m < 4; ++m) rs[ai][m] = rsqrtf(ssl[wr * 64 + fr + ai * 128 + m * 16] * (1.0f / DM) + EPS);
#pragma unroll
        for (int n = 0; n < 2; ++n) {
            const int f = f0 + 4 * n; const int fl = wc * 32 + 8 * fq + 4 * n;
            f32x4 cwg[4], cwv[4];
#pragma unroll
            for (int t = 0; t < 4; ++t) { cwg[t] = *(const LAS f32x4*)(cwl + t * 128 + fl); cwv[t] = *(const LAS f32x4*)(cwl + (4 + t) * 128 + fl); }
#pragma unroll
            for (int ai = 0; ai < 2; ++ai) {
                const int G = 2 * ai + wr; const int sb = (u.pm - 128) * 4 + G;
                f32x4 cg[4];
                conv_cols<0>(acc, u, ai, n, G, f, fr, rs[ai], samp, sb, cwg, cg, nullptr);
                conv_cols<1>(acc, u, ai, n, G, f, fr, rs[ai], samp, sb, cwv, cg, ACT + (size_t)(row0 + ai * 128) * FFP + f);
            }
            asm volatile("" ::: "memory");
        }
    }
};

DI int dest_row(int mode, int n) {
    if (mode == 1) { if (n >= 1536 && n < 3584) { const int hd = (n - 1536) >> 7, d = (n - 1536) & 127, half = d >> 6, i = d & 63; return 1536 + hd * 128 + 8 * (i >> 2) + 4 * half + (i & 3); } return n; }
    if (mode == 2) { const int gv = n >= FF ? 1 : 0, f = n - gv * FF; return 256 * (f >> 7) + 128 * gv + (f & 127); }
    return n;
}
DI void p0_transpose_item(const float* W, int K, int N, bf16_t* WT, int mode, const float* kscale, LAS float* scr, int item, int lane, int pitch = 0) {
    if (pitch == 0) pitch = K;
    const int nblk = N / 32, kb = item / nblk, nb = item % nblk, k0 = 64 * kb, n0 = 32 * nb;
    f32x4 wv[8];
#pragma unroll
    for (int i = 0; i < 8; ++i) wv[i] = *(const f32x4*)(W + (size_t)(k0 + 8 * i + (lane >> 3)) * N + n0 + 4 * (lane & 7));
    if (kscale) {
#pragma unroll
        for (int i = 0; i < 8; ++i) wv[i] = wv[i] * kscale[k0 + 8 * i + (lane >> 3)]; }
#pragma unroll
    for (int i = 0; i < 8; ++i) { LAS float* d = scr + (8 * i + (lane >> 3)) * 33 + 4 * (lane & 7); d[0] = wv[i][0]; d[1] = wv[i][1]; d[2] = wv[i][2]; d[3] = wv[i][3]; }
    asm volatile("s_waitcnt lgkmcnt(0)" ::: "memory");
    const int c = lane & 7;
#pragma unroll
    for (int j = 0; j < 4; ++j) { const int n = (lane >> 3) + 8 * j; const LAS float* s = scr + (8 * c) * 33 + n;
        u32x4 o; o.x = cvtpk(s[0 * 33], s[1 * 33]); o.y = cvtpk(s[2 * 33], s[3 * 33]); o.z = cvtpk(s[4 * 33], s[5 * 33]); o.w = cvtpk(s[6 * 33], s[7 * 33]);
        *(u32x4*)(WT + (size_t)dest_row(mode, n0 + n) * pitch + k0 + 8 * c) = o; }
    asm volatile("s_waitcnt lgkmcnt(0)" ::: "memory");
}
DI void rms_row_to_bf16(const float* xrow, const float* g, bf16_t* orow, int lane) {
    f32x4 v[8]; float s = 0.f;
#pragma unroll
    for (int j = 0; j < 8; ++j) { v[j] = *((const f32x4*)xrow + lane + 64 * j); s += (v[j][0] * v[j][0] + v[j][1] * v[j][1]) + (v[j][2] * v[j][2] + v[j][3] * v[j][3]); }
    const float rstd = rsqrtf(wave_sum(s) * (1.0f / DM) + EPS);
#pragma unroll
    for (int j = 0; j < 8; ++j) { const f32x4 gg = *((const f32x4*)g + lane + 64 * j); u32x2 w; w.x = cvtpk(v[j][0] * rstd * gg[0], v[j][1] * rstd * gg[1]); w.y = cvtpk(v[j][2] * rstd * gg[2], v[j][3] * rstd * gg[3]);
        *((u32x2*)orow + lane + 64 * j) = w; }
}
DI int dorig(int p) { return 64 * ((p >> 2) & 1) + 4 * (p >> 3) + (p & 3); }

DI void p0_prologue(const Ctx& C, LAS unsigned char* lds, int wave, bool first) {
    const int lane = lane_id(), tid = wave * 64 + lane;
    LAS float* scr = (LAS float*)(lds + wave * 16384);
    const int gw = blockIdx.x * 8 + wave, NGW = gridDim.x * 8;
    const int gt = blockIdx.x * 512 + tid, NGT = gridDim.x * 512;
    constexpr int I_IN = 32 * 400, I_BR = 16 * 64, I_O = 32 * 64, I_MEM = 32 * 64, I_UP = 32 * 352, I_DN = 88 * 64;
    constexpr int NITEMS = I_IN + 3 * I_BR + I_O + I_MEM + I_UP + I_DN;
    bf16_t* ws16 = (bf16_t*)C.ws;
    for (int it = gw; it < NITEMS; it += NGW) {
        int r = it;
        if (r < I_IN) { p0_transpose_item(C.w_in, DM, NIN, (bf16_t*)(C.ws + WS_WIN), 1, nullptr, scr, r, lane); continue; } r -= I_IN;
        if (r < 3 * I_BR) { const int z = r / I_BR; p0_transpose_item(C.w_br + (size_t)z * 1024 * DM, 1024, DM, (bf16_t*)(C.ws + WS_WBR) + (size_t)z * DM * 1024, 0, nullptr, scr, r % I_BR, lane); continue; } r -= 3 * I_BR;
        if (r < I_O) { p0_transpose_item(C.w_o, DM, DM, (bf16_t*)(C.ws + WS_WO), 0, nullptr, scr, r, lane); continue; } r -= I_O;
        if (r < I_MEM) { p0_transpose_item(C.w_mem, DM, DM, (bf16_t*)(C.ws + WS_WMEM), 0, nullptr, scr, r, lane); continue; } r -= I_MEM;
        if (r < I_UP) { p0_transpose_item(C.w_up, DM, FF2, (bf16_t*)(C.ws + WS_WUP), 2, C.g_ffn, scr, r, lane); continue; } r -= I_UP;
        p0_transpose_item(C.w_down, FF, DM, (bf16_t*)(C.ws + WS_WDN), 0, nullptr, scr, r, lane, FFP);
    }
    (void)ws16;
    bf16_t* U = (bf16_t*)C.out;
    for (int m = gw; m < MT + 1024; m += NGW) {
        if (m < MP) rms_row_to_bf16(C.xp + (size_t)m * DM, C.g_mix, U + (size_t)m * DM, lane);
        else if (m < MT) rms_row_to_bf16(C.xs + (size_t)(m - MP) * DM, C.g_mix, U + (size_t)m * DM, lane);
        else rms_row_to_bf16(C.memp + (size_t)(m - MT) * DM, C.g_mem, (bf16_t*)(C.ws + WS_MEMN) + (size_t)(m - MT) * DM, lane);
    }
    for (int i = gt; i < 2 * 8 * 256 * 128; i += NGT) { const int which = i >= 8 * 256 * 128, e = (i - which * 8 * 256 * 128) * 8;
        const float* src = (which ? C.cmemv : C.cmemk) + e; bf16_t* dst = (bf16_t*)(C.ws + (which ? WS_MV : WS_MK)) + (size_t)1024 * 1024 + e;
        store8bf(dst, *(const f32x4*)src, *(const f32x4*)(src + 4)); }
    for (int i = gt; i < 2 * 8 * 64 * 64; i += NGT) { const int which = i >= 8 * 64 * 64, j = i - which * 8 * 64 * 64, b = j >> 12, rem = j & 4095;
        const float* src = (which ? C.cswav : C.cswak) + ((size_t)b * 128 + 64) * 256 + rem * 4; float* dst = C.out + (which ? O_SWAV_S : O_SWAK_S) + (size_t)b * 128 * 256 + rem * 4;
        *(f32x4*)dst = *(const f32x4*)src; }
    for (int i = gt; i < 64 * 128 * 128; i += NGT) { const int bh = i >> 14, e = (i >> 7) & 127, p = i & 127;
        ((bf16_t*)(C.ws + WS_S0T))[i] = (bf16_t)(cvtpk(C.sret[((size_t)bh * 128 + dorig(p)) * 128 + e], 0.f) & 0xffffu); }
    float* ss = (float*)(C.ws + WS_CTL);
    for (int i = gt; i < 2 * MT; i += NGT) ss[i] = 0.f;
    if (gt == 0) { if (first) *(unsigned*)(C.ws + WS_BAR) = 0u; *(unsigned*)(C.ws + WS_BAR + 256) = 0u; *(unsigned*)(C.ws + WS_BAR + 512) = 0u; }
}

#define MFMA32(a, b, c) __builtin_amdgcn_mfma_f32_32x32x16_bf16((a), (b), (c), 0, 0, 0)
typedef short v4i16_t __attribute__((ext_vector_type(4)));
DI s16x4 tr_read(const LAS unsigned char* p) { return __builtin_bit_cast(s16x4, __builtin_amdgcn_ds_read_tr16_b64_v4i16((LAS v4i16_t*)p)); }
DI bf16x8 tr_pair(const LAS unsigned char* tile, int stride, int rlo, int rhi, int col0, int lane) {
    const int q4 = (lane & 15) >> 2, p = lane & 3, blk = (lane >> 4) & 1;
    const s16x4 lo = tr_read(tile + (rlo + q4) * stride + (col0 + 16 * blk + 4 * p) * 2);
    const s16x4 hi = tr_read(tile + (rhi + q4) * stride + (col0 + 16 * blk + 4 * p) * 2);
    return __builtin_shufflevector(lo, hi, 0, 1, 2, 3, 4, 5, 6, 7);
}
DI bf16x8 pack_step(const f32x16& x, int s) {
    u32x4 p; p.x = cvtpk(x[8 * s], x[8 * s + 1]); p.y = cvtpk(x[8 * s + 2], x[8 * s + 3]); p.z = cvtpk(x[8 * s + 4], x[8 * s + 5]); p.w = cvtpk(x[8 * s + 6], x[8 * s + 7]);
    return __builtin_bit_cast(bf16x8, p);
}
DI void store_pair16(bf16_t* rowp, u32x2 a, u32x2 b, int g, int hh) {
    auto r0 = __builtin_amdgcn_permlane32_swap(a.x, b.x, false, false); a.x = r0[0]; b.x = r0[1];
    auto r1 = __builtin_amdgcn_permlane32_swap(a.y, b.y, false, false); a.y = r1[0]; b.y = r1[1];
    *(u32x4*)(rowp + 8 * g + 8 * hh) = (u32x4){a.x, a.y, b.x, b.y};
}
DI void store_block32(bf16_t* rowp, const f32x16& o, float sc, int hh) {
#pragma unroll
    for (int g = 0; g < 4; g += 2) {
        u32x2 a, b;
        a.x = cvtpk(o[4 * g] * sc, o[4 * g + 1] * sc); a.y = cvtpk(o[4 * g + 2] * sc, o[4 * g + 3] * sc);
        b.x = cvtpk(o[4 * g + 4] * sc, o[4 * g + 5] * sc); b.y = cvtpk(o[4 * g + 6] * sc, o[4 * g + 7] * sc);
        store_pair16(rowp, a, b, g, hh);
    }
}
DI int crow(int i, int h) { return (i & 3) + 8 * (i >> 2) + 4 * h; }
DI f32x16 zero16() { f32x16 z; for (int i = 0; i < 16; ++i) z[i] = 0.f; return z; }
DI size_t seq_rowbase(int sq) { return sq < 4 ? (size_t)sq * 8192 : (size_t)MP + (size_t)(sq - 4) * 64; }

DI void swa_unit(const Ctx& C, LAS unsigned char* lds, int sq, int hk, int c, int w) {
    const int lane = lane_id(), tid = w * 64 + lane, r = lane & 31, hh = lane >> 5;
    constexpr int KSTR = 144;
    LAS unsigned char* Kt = lds; LAS unsigned char* Vt = lds + 192 * KSTR;
    const bool samp = sq >= 4;
    const size_t rowbase = seq_rowbase(sq) + (size_t)c * 64;
    const bf16_t* KS = (const bf16_t*)(C.ws + WS_KS); const bf16_t* VS = (const bf16_t*)(C.ws + WS_VS); bf16_t* QS = (bf16_t*)(C.ws + WS_QS);
    for (int i = tid; i < 192 * 8; i += 512) {
        const int row = i >> 3, ch = i & 7, j = row >> 6, rr = row & 63;
        u32x4 kv = (u32x4){0u, 0u, 0u, 0u}, vv = kv;
        if (samp && j < 2) {
            const size_t o = (((size_t)(sq - 4) * 128 + row) * 4 + hk) * 64 + ch * 8;
            const f32x4 k0 = *(const f32x4*)(C.cswak + o), k1 = *(const f32x4*)(C.cswak + o + 4), v0 = *(const f32x4*)(C.cswav + o), v1 = *(const f32x4*)(C.cswav + o + 4);
            kv.x = cvtpk(k0[0], k0[1]); kv.y = cvtpk(k0[2], k0[3]); kv.z = cvtpk(k1[0], k1[1]); kv.w = cvtpk(k1[2], k1[3]);
            vv.x = cvtpk(v0[0], v0[1]); vv.y = cvtpk(v0[2], v0[3]); vv.z = cvtpk(v1[0], v1[1]); vv.w = cvtpk(v1[2], v1[3]);
        } else {
            const int cc = samp ? 0 : c - 2 + j;
            if (cc >= 0) { const size_t gr = seq_rowbase(sq) + (size_t)cc * 64 + rr; kv = *(const u32x4*)(KS + gr * 256 + hk * 64 + ch * 8); vv = *(const u32x4*)(VS + gr * 256 + hk * 64 + ch * 8); }
        }
        *(LAS u32x4*)(Kt + row * KSTR + ch * 16) = kv; *(LAS u32x4*)(Vt + row * KSTR + ch * 16) = vv;
    }
    const int g = w >> 1, half = w & 1, head = hk * 4 + g;
    bf16_t* qp = QS + (rowbase + 32 * half + r) * 1024 + head * 64;
    bf16x8 qf[4];
#pragma unroll
    for (int s = 0; s < 4; ++s) qf[s] = *(const bf16x8*)(qp + 16 * s + 8 * hh);
    __syncthreads();
    const int kb0 = samp ? 0 : (c >= 2 ? 0 : (2 - c) * 2);
    f32x16 acc[6];
#pragma unroll
    for (int kb = 0; kb < 6; ++kb) { acc[kb] = zero16();
        if (kb >= kb0) {
#pragma unroll
            for (int s = 0; s < 4; ++s) { const bf16x8 a = *(const LAS bf16x8*)(Kt + (32 * kb + r) * KSTR + (16 * s + 8 * hh) * 2); acc[kb] = MFMA32(a, qf[s], acc[kb]); } } }
    const float sk = C.sink[head] * LOG2E;
    float mx = sk;
#pragma unroll
    for (int kb = 0; kb < 6; ++kb) if (kb >= kb0) {
#pragma unroll
        for (int i = 0; i < 16; ++i) mx = fmaxf(mx, acc[kb][i]); }
    mx = fmaxf(mx, __shfl_xor(mx, 32));
    float l = 0.f;
#pragma unroll
    for (int kb = 0; kb < 6; ++kb) if (kb >= kb0) {
#pragma unroll
        for (int i = 0; i < 16; ++i) { const float p = fexp2(acc[kb][i] - mx); acc[kb][i] = p; l += p; } }
    l += __shfl_xor(l, 32); l += fexp2(sk - mx);
    f32x16 o[2]; o[0] = zero16(); o[1] = zero16();
#pragma unroll
    for (int kb = 0; kb < 6; ++kb) if (kb >= kb0) {
#pragma unroll
        for (int s = 0; s < 2; ++s) { const bf16x8 pb = pack_step(acc[kb], s); const int r0 = 32 * kb + 16 * s + 4 * hh;
#pragma unroll
            for (int db = 0; db < 2; ++db) { const bf16x8 a = tr_pair(Vt, KSTR, r0, r0 + 8, 32 * db, lane); o[db] = MFMA32(a, pb, o[db]); } } }
    const float inv = 1.0f / l;
#pragma unroll
    for (int db = 0; db < 2; ++db) store_block32(qp + 32 * db, o[db], inv, hh);
    __syncthreads();
}

DI void mem_unit(const Ctx& C, LAS unsigned char* lds, int sq, int h, int qt, int w) {
    const int lane = lane_id(), tid = w * 64 + lane, r = lane & 31, hh = lane >> 5;
    constexpr int MSTR = 272;
    const bool samp = sq >= 4;
    const size_t qrow = samp ? seq_rowbase(sq) + 32 * (w & 1) + r : seq_rowbase(sq) + (size_t)qt * 256 + 32 * w + r;
    const bool do_store = !samp || w < 2;
    bf16_t* qp = (bf16_t*)(C.ws + WS_QM) + qrow * 1024 + h * 256;
    const bf16_t* Kg = (const bf16_t*)(C.ws + WS_MK) + (size_t)sq * 256 * 1024 + h * 256; const bf16_t* Vg = (const bf16_t*)(C.ws + WS_MV) + (size_t)sq * 256 * 1024 + h * 256;
    f32x16 acc[8];
#pragma unroll
    for (int mb = 0; mb < 8; ++mb) acc[mb] = zero16();
#pragma unroll 1
    for (int dh = 0; dh < 2; ++dh) {
        __syncthreads();
        for (int i = tid; i < 256 * 16; i += 512) { const int row = i >> 4, ch = i & 15; *(LAS u32x4*)(lds + row * MSTR + ch * 16) = *(const u32x4*)(Kg + (size_t)row * 1024 + dh * 128 + ch * 8); }
        bf16x8 qf[8];
#pragma unroll
        for (int s = 0; s < 8; ++s) qf[s] = *(const bf16x8*)(qp + dh * 128 + 16 * s + 8 * hh);
        __syncthreads();
#pragma unroll
        for (int mb = 0; mb < 8; ++mb)
#pragma unroll
            for (int s = 0; s < 8; ++s) { const bf16x8 a = *(const LAS bf16x8*)(lds + (32 * mb + r) * MSTR + (16 * s + 8 * hh) * 2); acc[mb] = MFMA32(a, qf[s], acc[mb]); }
    }
    float mx = -3.0e38f;
#pragma unroll
    for (int mb = 0; mb < 8; ++mb)
#pragma unroll
        for (int i = 0; i < 16; ++i) mx = fmaxf(mx, acc[mb][i]);
    mx = fmaxf(mx, __shfl_xor(mx, 32));
    float l = 0.f; bf16x8 pb[16];
#pragma unroll
    for (int mb = 0; mb < 8; ++mb) {
#pragma unroll
        for (int i = 0; i < 16; ++i) { const float p = fexp2(acc[mb][i] - mx); acc[mb][i] = p; l += p; }
        pb[2 * mb] = pack_step(acc[mb], 0); pb[2 * mb + 1] = pack_step(acc[mb], 1); }
    l += __shfl_xor(l, 32);
    const float inv = 1.0f / l;
#pragma unroll 1
    for (int dh = 0; dh < 2; ++dh) {
        __syncthreads();
        for (int i = tid; i < 256 * 16; i += 512) { const int row = i >> 4, ch = i & 15; *(LAS u32x4*)(lds + row * MSTR + ch * 16) = *(const u32x4*)(Vg + (size_t)row * 1024 + dh * 128 + ch * 8); }
        __syncthreads();
        f32x16 o[4];
#pragma unroll
        for (int db = 0; db < 4; ++db) o[db] = zero16();
#pragma unroll
        for (int ks = 0; ks < 16; ++ks) { const int r0 = 32 * (ks >> 1) + 16 * (ks & 1) + 4 * hh;
#pragma unroll
            for (int db = 0; db < 4; ++db) { const bf16x8 a = tr_pair(lds, MSTR, r0, r0 + 8, 32 * db, lane); o[db] = MFMA32(a, pb[ks], o[db]); } }
        if (do_store) {
#pragma unroll
            for (int db = 0; db < 4; ++db) store_block32(qp + dh * 128 + 32 * db, o[db], inv, hh); }
    }
    __syncthreads();
}

DI bf16_t* ut_ptr(const Ctx& C, int sq, int h, int c) { const size_t idx = sq < 4 ? ((size_t)(sq * 8 + h) * 128 + c) : (size_t)4096 + (size_t)(sq - 4) * 8 + h; return (bf16_t*)C.out + idx * 16384; }
DI void stage_rows128(LAS unsigned char* dst, const bf16_t* src, int nrows, int tid) {
    for (int i = tid; i < nrows * 16; i += 512) { const int row = i >> 4, ch = i & 15; *(LAS u32x4*)(dst + row * 272 + ch * 16) = *(const u32x4*)(src + (size_t)row * 1024 + ch * 8); }
}
DI void retA_unit(const Ctx& C, LAS unsigned char* lds, int sq, int h, int c, int w) {
    const int lane = lane_id(), tid = w * 64 + lane, r = lane & 31, hh = lane >> 5;
    constexpr int RSTR = 272;
    LAS unsigned char* Kt = lds; LAS unsigned char* Vt = lds + 64 * RSTR;
    const size_t rowbase = seq_rowbase(sq) + (size_t)c * 64;
    stage_rows128(Kt, (const bf16_t*)(C.ws + WS_KR) + rowbase * 1024 + h * 128, 64, tid);
    stage_rows128(Vt, (const bf16_t*)(C.ws + WS_VR) + rowbase * 1024 + h * 128, 64, tid);
    __syncthreads();
    const int eb = w >> 1, db0 = (w & 1) * 2;
    f32x16 acc[2]; acc[0] = zero16(); acc[1] = zero16();
#pragma unroll
    for (int s = 0; s < 4; ++s) { const int r0 = 16 * s + 8 * hh;
        const bf16x8 b = tr_pair(Vt, RSTR, r0, r0 + 4, 32 * eb, lane);
#pragma unroll
        for (int x = 0; x < 2; ++x) { const bf16x8 a = tr_pair(Kt, RSTR, r0, r0 + 4, 32 * (db0 + x), lane); acc[x] = MFMA32(a, b, acc[x]); } }
    bf16_t* U = ut_ptr(C, sq, h, c) + (size_t)(32 * eb + r) * 128;
#pragma unroll
    for (int x = 0; x < 2; ++x) store_block32(U + 32 * (db0 + x), acc[x], 1.0f, hh);
    __syncthreads();
}

DI void ret_scan(const Ctx& C, int wave) {
    const int tid = wave * 64 + lane_id();
    const int gt = blockIdx.x * 512 + tid, NGT = gridDim.x * 512;
    for (int it = gt; it < 32 * 4096 + 64 * 4096; it += NGT) {
        if (it < 32 * 4096) {
            const int bh = it >> 12, e = (it >> 5) & 127, p0 = (it & 31) * 4, h = bh & 7;
            const float g64 = fexp2(64.f * log2gamma(h));
            bf16_t* U = (bf16_t*)C.out + (size_t)bh * 128 * 16384 + e * 128 + p0;
            float s0 = 0.f, s1 = 0.f, s2 = 0.f, s3 = 0.f;
#pragma unroll 1
            for (int c0 = 0; c0 < 128; c0 += 16) {
                u32x2 u[16];
#pragma unroll
                for (int k = 0; k < 16; ++k) u[k] = *(const u32x2*)(U + (size_t)(c0 + k) * 16384);
#pragma unroll
                for (int k = 0; k < 16; ++k) { s0 = g64 * (s0 + bflo(u[k].x)); s1 = g64 * (s1 + bfhi(u[k].x)); s2 = g64 * (s2 + bflo(u[k].y)); s3 = g64 * (s3 + bfhi(u[k].y));
                    u32x2 wv; wv.x = cvtpk(s0, s1); wv.y = cvtpk(s2, s3); *(u32x2*)(U + (size_t)(c0 + k) * 16384) = wv; }
            }
            float* O = C.out + O_RET_P + (size_t)bh * 16384 + e;
            O[(size_t)dorig(p0) * 128] = s0; O[(size_t)dorig(p0 + 1) * 128] = s1; O[(size_t)dorig(p0 + 2) * 128] = s2; O[(size_t)dorig(p0 + 3) * 128] = s3;
        } else {
            const int j = it - 32 * 4096, bh = j >> 12, e = (j >> 5) & 127, p0 = (j & 31) * 4, h = bh & 7;
            const float g64 = fexp2(64.f * log2gamma(h));
            const u32x2 u = *(const u32x2*)((const bf16_t*)C.out + ((size_t)4096 + bh) * 16384 + e * 128 + p0);
            const float uu[4] = {bflo(u.x), bfhi(u.x), bflo(u.y), bfhi(u.y)};
#pragma unroll
            for (int k = 0; k < 4; ++k) { const size_t o = ((size_t)bh * 128 + dorig(p0 + k)) * 128 + e; C.out[O_RET_S + o] = g64 * (C.sret[o] + uu[k]); }
        }
    }
}

struct RetCRegs { u32x4 kvq[6]; u32x4 st[4]; };
DI void retC_decode(int u, int& sq, int& h, int& c) { if (u < 4096) { sq = u >> 10; h = (u >> 7) & 7; c = u & 127; } else { const int x = u - 4096; sq = 4 + (x >> 3); h = x & 7; c = 0; } }
DI void retC_get(const Ctx& C, int u, int tid, RetCRegs& R) {
    int sq, h, c; retC_decode(u, sq, h, c);
    const size_t rowbase = seq_rowbase(sq) + (size_t)c * 64; const bool samp = sq >= 4, has_prev = samp || c > 0;
    const bf16_t* Kg = (const bf16_t*)(C.ws + WS_KR) + rowbase * 1024 + h * 128; const bf16_t* Vg = (const bf16_t*)(C.ws + WS_VR) + rowbase * 1024 + h * 128; const bf16_t* Qg = (const bf16_t*)(C.ws + WS_QR) + rowbase * 1024 + h * 128;
#pragma unroll
    for (int k = 0; k < 2; ++k) { const int i = tid + 512 * k, row = i >> 4, ch = i & 15; const size_t o = (size_t)row * 1024 + ch * 8;
        R.kvq[k] = *(const u32x4*)(Kg + o); R.kvq[2 + k] = *(const u32x4*)(Vg + o); R.kvq[4 + k] = *(const u32x4*)(Qg + o); }
    if (has_prev) { const bf16_t* S = samp ? (const bf16_t*)(C.ws + WS_S0T) + (size_t)((sq - 4) * 8 + h) * 16384 : ut_ptr(C, sq, h, c - 1);
#pragma unroll
        for (int k = 0; k < 4; ++k) { const int i = tid + 512 * k, row = i >> 4, ch = i & 15; R.st[k] = *(const u32x4*)(S + (size_t)row * 128 + ch * 8); } }
    else {
#pragma unroll
        for (int k = 0; k < 4; ++k) R.st[k] = (u32x4){0u, 0u, 0u, 0u}; }
}
DI void retC_put(LAS unsigned char* lds, int tid, const RetCRegs& R) {
    constexpr int RSTR = 272;
#pragma unroll
    for (int k = 0; k < 2; ++k) { const int i = tid + 512 * k, row = i >> 4, ch = i & 15;
        *(LAS u32x4*)(lds + row * RSTR + ch * 16) = R.kvq[k]; *(LAS u32x4*)(lds + (64 + row) * RSTR + ch * 16) = R.kvq[2 + k]; *(LAS u32x4*)(lds + (128 + row) * RSTR + ch * 16) = R.kvq[4 + k]; }
#pragma unroll
    for (int k = 0; k < 4; ++k) { const int i = tid + 512 * k, row = i >> 4, ch = i & 15; *(LAS u32x4*)(lds + (192 + row) * RSTR + ch * 16) = R.st[k]; }
}
DI void retC_unit(const Ctx& C, LAS unsigned char* lds, int sq, int h, int c, int w) {
    const int lane = lane_id(), tid = w * 64 + lane, r = lane & 31, hh = lane >> 5;
    constexpr int RSTR = 272;
    LAS unsigned char* Kt = lds; LAS unsigned char* Vt = lds + 64 * RSTR; LAS unsigned char* Qt = lds + 128 * RSTR; LAS unsigned char* St = lds + 192 * RSTR;
    LAS float* red = (LAS float*)(lds + 320 * RSTR);
    const size_t rowbase = seq_rowbase(sq) + (size_t)c * 64;
    const bool samp = sq >= 4, has_prev = samp || c > 0;
    bf16_t* QR = (bf16_t*)(C.ws + WS_QR);
    const int nh = w & 1, eq = w >> 1;
    bf16x8 qf[8];
#pragma unroll
    for (int s = 0; s < 8; ++s) qf[s] = *(const LAS bf16x8*)(Qt + (32 * nh + r) * RSTR + (16 * s + 8 * hh) * 2);
    f32x16 o = zero16();
#pragma unroll
    for (int mb = 0; mb < 2; ++mb) if (mb <= nh) {
        f32x16 P = zero16();
#pragma unroll
        for (int s = 0; s < 8; ++s) { const bf16x8 a = *(const LAS bf16x8*)(Kt + (32 * mb + r) * RSTR + (16 * s + 8 * hh) * 2); P = MFMA32(a, qf[s], P); }
        if (mb == nh) {
#pragma unroll
            for (int i = 0; i < 16; ++i) if (crow(i, hh) > r) P[i] = 0.f; }
#pragma unroll
        for (int s = 0; s < 2; ++s) { const bf16x8 pb = pack_step(P, s); const int r0 = 32 * mb + 16 * s + 4 * hh; const bf16x8 a = tr_pair(Vt, RSTR, r0, r0 + 8, 32 * eq, lane); o = MFMA32(a, pb, o); }
    }
    if (has_prev) {
#pragma unroll
        for (int s = 0; s < 8; ++s) { const bf16x8 a = *(const LAS bf16x8*)(St + (32 * eq + r) * RSTR + (16 * s + 8 * hh) * 2); o = MFMA32(a, qf[s], o); } }
    float ss = 0.f;
#pragma unroll
    for (int i = 0; i < 16; ++i) ss += o[i] * o[i];
    ss += __shfl_xor(ss, 32);
    if (hh == 0) red[(32 * nh + r) * 4 + eq] = ss;
    __syncthreads();
    const f32x4 rr = *(const LAS f32x4*)(red + (32 * nh + r) * 4);
    const float rstd = rsqrtf(((rr[0] + rr[1]) + (rr[2] + rr[3])) * (1.0f / 128.0f) + EPS);
    const size_t orow = (rowbase + 32 * nh + r) * 1024 + h * 128 + 32 * eq;
    const bf16_t* GR = (const bf16_t*)(C.ws + WS_GR);
    u32x2 gt[4];
#pragma unroll
    for (int g4 = 0; g4 < 4; ++g4) gt[g4] = *(const u32x2*)(GR + orow + 8 * g4 + 4 * hh);
#pragma unroll
    for (int g = 0; g < 4; g += 2) { u32x2 a, b;
        a.x = cvtpk(o[4 * g] * rstd * bflo(gt[g].x), o[4 * g + 1] * rstd * bfhi(gt[g].x)); a.y = cvtpk(o[4 * g + 2] * rstd * bflo(gt[g].y), o[4 * g + 3] * rstd * bfhi(gt[g].y));
        b.x = cvtpk(o[4 * g + 4] * rstd * bflo(gt[g + 1].x), o[4 * g + 5] * rstd * bfhi(gt[g + 1].x)); b.y = cvtpk(o[4 * g + 6] * rstd * bflo(gt[g + 1].y), o[4 * g + 7] * rstd * bfhi(gt[g + 1].y));
        store_pair16(QR + orow, a, b, g, hh); }
    __syncthreads();
}

DI void conv_fixup(const Ctx& C, int wave) {
    const int tid = wave * 64 + lane_id();
    const int gt = blockIdx.x * 512 + tid, NGT = gridDim.x * 512;
    const float* RAW = (const float*)(C.ws + WS_RAW); bf16_t* ACT = (bf16_t*)(C.ws + WS_ACT);
    constexpr int F4 = FF / 4;
    for (int it = gt; it < 512 * F4; it += NGT) {
        const int grp = it / F4, f = (it % F4) * 4;
        if ((grp & 127) == 0) continue;
        const float* cur = RAW + (size_t)grp * 4 * 2 * FF + f; const float* prv = RAW + (size_t)(grp - 1) * 4 * 2 * FF + f;
        f32x4 c0[2], c1[2];
#pragma unroll
        for (int gv = 0; gv < 2; ++gv) {
            const f32x4 w0 = *(const f32x4*)(C.w_conv + gv * FF + f), w1 = *(const f32x4*)(C.w_conv + FF2 + gv * FF + f), w2 = *(const f32x4*)(C.w_conv + 2 * FF2 + gv * FF + f), bb = *(const f32x4*)(C.b_conv + gv * FF + f);
            const f32x4 p62 = *(const f32x4*)(prv + (size_t)(2 * 2 + gv) * FF), p63 = *(const f32x4*)(prv + (size_t)(3 * 2 + gv) * FF), a0 = *(const f32x4*)(cur + (size_t)(0 * 2 + gv) * FF), a1 = *(const f32x4*)(cur + (size_t)(1 * 2 + gv) * FF);
            c0[gv] = bb + w0 * p62 + w1 * p63 + w2 * a0; c1[gv] = bb + w0 * p63 + w1 * a0 + w2 * a1;
        }
        u32x2 o0, o1;
        o0.x = cvtpk(silu_f(c0[0][0]) * c0[1][0], silu_f(c0[0][1]) * c0[1][1]); o0.y = cvtpk(silu_f(c0[0][2]) * c0[1][2], silu_f(c0[0][3]) * c0[1][3]);
        o1.x = cvtpk(silu_f(c1[0][0]) * c1[1][0], silu_f(c1[0][1]) * c1[1][1]); o1.y = cvtpk(silu_f(c1[0][2]) * c1[1][2], silu_f(c1[0][3]) * c1[1][3]);
        *(u32x2*)(ACT + (size_t)(grp * 64) * FFP + f) = o0; *(u32x2*)(ACT + (size_t)(grp * 64 + 1) * FFP + f) = o1;
    }
}

DI void conv_merged_s(const Ctx& C, int wave) {
    const int gw = blockIdx.x * 8 + wave, lane = lane_id();
    if (gw < MS) {
        const f32x4* s = (const f32x4*)C.out + (size_t)gw * (DM / 4); u32x2* d = (u32x2*)((bf16_t*)(C.ws + WS_MERGED) + (size_t)(MP + gw) * DM);
#pragma unroll
        for (int j = 0; j < 8; ++j) { f32x4 v = s[lane + 64 * j];
#pragma unroll
            for (int q = 1; q < 6; ++q) v += s[(size_t)q * (MS * DM / 4) + lane + 64 * j];
            u32x2 w; w.x = cvtpk(v[0], v[1]); w.y = cvtpk(v[2], v[3]); d[lane + 64 * j] = w; }
        asm volatile("s_waitcnt vmcnt(0)" ::: "memory");
        __builtin_amdgcn_fence(__ATOMIC_RELEASE, "agent");
        if (lane == 0) __hip_atomic_fetch_add((unsigned*)(C.ws + WS_BAR + 256), 1u, __ATOMIC_RELAXED, __HIP_MEMORY_SCOPE_AGENT);
    }
}
DI void conv_h_s(const Ctx& C, int wave) {
    const int gw = blockIdx.x * 8 + wave, lane = lane_id();
    if (gw < MS) {
        const f32x4* s = (const f32x4*)C.out + (size_t)gw * (DM / 4); const f32x4* x = (const f32x4*)C.xs + (size_t)gw * (DM / 4);
        f32x4* h = (f32x4*)(C.out + (size_t)(MP + gw) * DM); u32x2* d = (u32x2*)((bf16_t*)(C.ws + WS_H1B) + (size_t)(MP + gw) * DM); float ss = 0.f;
#pragma unroll
        for (int j = 0; j < 8; ++j) { f32x4 v = x[lane + 64 * j];
#pragma unroll
            for (int q = 0; q < 4; ++q) v += s[(size_t)q * (MS * DM / 4) + lane + 64 * j];
            h[lane + 64 * j] = v; u32x2 w; w.x = cvtpk(v[0], v[1]); w.y = cvtpk(v[2], v[3]); d[lane + 64 * j] = w; ss += (v[0] * v[0] + v[1] * v[1]) + (v[2] * v[2] + v[3] * v[3]); }
        ss = wave_sum(ss);
        if (lane == 0) ((float*)(C.ws + WS_CTL))[MP + gw] = ss;
        asm volatile("s_waitcnt vmcnt(0)" ::: "memory");
        __builtin_amdgcn_fence(__ATOMIC_RELEASE, "agent");
        if (lane == 0) __hip_atomic_fetch_add((unsigned*)(C.ws + WS_BAR + 512), 1u, __ATOMIC_RELAXED, __HIP_MEMORY_SCOPE_AGENT);
    }
}
DI void final_norm(const Ctx& C, int wave) {
    const int lane = lane_id();
    const int gw = blockIdx.x * 8 + wave, NGW = gridDim.x * 8;
    for (int m = gw; m < MT; m += NGW) {
        f32x4* row = (f32x4*)(C.out + (size_t)m * DM);
        f32x4 v[8]; float s = 0.f;
        if (m < MP) {
            const u32x2* hb = (const u32x2*)((const bf16_t*)(C.ws + WS_H1B) + (size_t)m * DM);
#pragma unroll
            for (int j = 0; j < 8; ++j) { const u32x2 h = hb[lane + 64 * j]; v[j] = (f32x4){bflo(h.x), bfhi(h.x), bflo(h.y), bfhi(h.y)}; }
        } else {
            const f32x4* pd = (const f32x4*)(C.ws + WS_VR) + (size_t)(m - MP) * (DM / 4);
#pragma unroll
            for (int j = 0; j < 8; ++j) { v[j] = row[lane + 64 * j];
#pragma unroll
                for (int q = 0; q < 11; ++q) v[j] += pd[(size_t)q * (MS * DM / 4) + lane + 64 * j]; }
        }
#pragma unroll
        for (int j = 0; j < 8; ++j) s += (v[j][0] * v[j][0] + v[j][1] * v[j][1]) + (v[j][2] * v[j][2] + v[j][3] * v[j][3]);
        const float rstd = rsqrtf(wave_sum(s) * (1.0f / DM) + EPS);
#pragma unroll
        for (int j = 0; j < 8; ++j) { const f32x4 g = *((const f32x4*)C.g_final + lane + 64 * j); row[lane + 64 * j] = v[j] * rstd * g; }
    }
}

#define XB_TMO      128
#define XB_XCNT(j)  (256  + 64 * (j))
#define XB_XSUB(j)  (1280 + 64 * (j))
#define XB_XGEN(j)  (2304 + 64 * (j))
#define XB_TOP      3328
#define XB_TOPGEN   3392
#define XCD_BAR_WORDS 3456
#define XB_SPIN_CAP (1u << 18)
constexpr size_t WS_XBAR = 768 * 1024;
DI unsigned xb_ld(unsigned* p)              { return __hip_atomic_load(p, __ATOMIC_RELAXED, __HIP_MEMORY_SCOPE_AGENT); }
DI unsigned xb_add(unsigned* p, unsigned v) { return __hip_atomic_fetch_add(p, v, __ATOMIC_RELAXED, __HIP_MEMORY_SCOPE_AGENT); }
DI unsigned xb_xcc_id() { return (unsigned)__builtin_amdgcn_s_getreg((3 << 11) | 20) & 0xFu; }
#define XB_SPIN(cond, bar) do { unsigned _sp = 0; while (cond) { __builtin_amdgcn_s_sleep(1); \
    if ((++_sp & 255u) == 0u) { if (xb_ld(&(bar)[XB_TMO])) break; if (_sp > XB_SPIN_CAP) { atomicAdd(&(bar)[XB_TMO], 1u); break; } } } } while (0)
struct XcdBarrier { unsigned* bar; unsigned x; volatile LAS unsigned* st; };
DI void xcd_barrier_complete(unsigned* bar, unsigned x, unsigned& nloc, unsigned& nx) {
    const unsigned G = gridDim.x;
    unsigned sum, cnt, mine, sp = 0u;
    for (;;) {
        sum = 0u; cnt = 0u; mine = 0u;
#pragma unroll
        for (unsigned j = 0; j < 16; ++j) { const unsigned c = xb_ld(&bar[XB_XCNT(j)]); sum += c; cnt += (c > 0u) ? 1u : 0u; mine = (j == x) ? c : mine; }
        if (sum == G) break;
        __builtin_amdgcn_s_sleep(1);
        if ((++sp & 255u) == 0u) { if (xb_ld(&bar[XB_TMO])) break; if (sp > XB_SPIN_CAP) { atomicAdd(&bar[XB_TMO], 1u); break; } }
    }
    nloc = mine > 0u ? mine : 1u; nx = cnt > 0u ? cnt : 1u;
}
DI void xcd_barrier(const XcdBarrier& b, int wave) {
    asm volatile("s_waitcnt vmcnt(0)" ::: "memory");
    __syncthreads();
    if (wave == 0 && lane_id() == 0) {
        unsigned* bar = b.bar;
        __builtin_amdgcn_s_waitcnt(0);
        unsigned nloc = b.st[0], nx = b.st[1];
        if (nloc == 0u) { xcd_barrier_complete(bar, b.x, nloc, nx); b.st[0] = nloc; b.st[1] = nx; }
        const unsigned old = xb_add(&bar[XB_XSUB(b.x)], 1u);
        const unsigned gen = old / nloc;
        if (old + 1u == (gen + 1u) * nloc) {
            __builtin_amdgcn_fence(__ATOMIC_RELEASE, "agent");
            asm volatile("s_waitcnt vmcnt(0)" ::: "memory");
            const unsigned og = xb_add(&bar[XB_TOP], 1u);
            const unsigned tg = og / nx;
            if (og + 1u == (tg + 1u) * nx) xb_add(&bar[XB_TOPGEN], 1u);
            else XB_SPIN(xb_ld(&bar[XB_TOPGEN]) == tg, bar);
            __builtin_amdgcn_fence(__ATOMIC_ACQUIRE, "agent");
            xb_add(&bar[XB_XGEN(b.x)], 1u);
            asm volatile("s_waitcnt vmcnt(0)" ::: "memory");
        } else {
            XB_SPIN(xb_ld(&bar[XB_XGEN(b.x)]) == gen, bar);
            __builtin_amdgcn_fence(__ATOMIC_ACQUIRE, "agent");
            asm volatile("s_waitcnt vmcnt(0)" ::: "memory");
        }
    }
    __syncthreads();
}

constexpr int LDS_BYTES = 147456;
#define MKCTX Ctx C; C.xp = args.in[0]; C.xs = args.in[1]; C.memp = args.in[2]; C.cswak = args.in[3]; C.cswav = args.in[4]; C.sret = args.in[5]; C.sconv = args.in[6]; C.cmemk = args.in[7]; C.cmemv = args.in[8]; C.g_mix = args.in[9]; C.w_in = args.in[10]; C.b_gate = args.in[11]; C.sink = args.in[12]; C.w_br = args.in[13]; C.w_o = args.in[14]; C.g_mem = args.in[15]; C.w_mem = args.in[16]; C.g_ffn = args.in[17]; C.w_up = args.in[18]; C.w_conv = args.in[19]; C.b_conv = args.in[20]; C.w_down = args.in[21]; C.g_final = args.in[22]; C.out = args.out; C.ws = args.ws;
__global__ void __launch_bounds__(512, 2) fwd(Args args) {
    extern __shared__ __attribute__((aligned(16))) unsigned char lds_raw[];
    LAS unsigned char* lds = (LAS unsigned char*)lds_raw;
    cg::grid_group grid = cg::this_grid();
    const int wave = __builtin_amdgcn_readfirstlane(threadIdx.x >> 6);
    XcdBarrier xbar; xbar.bar = (unsigned*)(args.ws + WS_XBAR); xbar.x = xb_xcc_id(); xbar.st = (volatile LAS unsigned*)(lds + 131072 + 64);
    if (wave == 0 && lane_id() == 0) { xbar.st[0] = 0u; xbar.st[1] = 0u; (void)xb_add(&xbar.bar[XB_XCNT(xbar.x)], 1u); }
    __syncthreads();
#ifndef PROBE_PREFIX
#define PROBE_PREFIX 0
#endif
    const int G = gridDim.x, bid = blockIdx.x;
    for (int pass = (PROBE_PREFIX ? 0 : 1); pass < 2; ++pass) {
    const int lo = 0, hi = (pass == 0) ? PROBE_PREFIX : 11;
#ifndef PH_MASK
#define PH_MASK 0x7ff
#endif
#define IN(k) (((PH_MASK >> (k)) & 1) && lo <= (k) && (k) < hi)
#ifndef REP_MASK
#define REP_MASK 0
#endif
#define SEAM(k) do { if (!IN(k)) break; if ((k) == 0) grid.sync(); else xcd_barrier(xbar, wave); } while (0)
#define NREP(k) (1 + ((REP_MASK >> (k)) & 1))
    if (IN(0)) { MKCTX; p0_prologue(C, lds, wave, pass == (PROBE_PREFIX ? 0 : 1)); }
    SEAM(0);
    if (IN(1)) {
        MKCTX;
        SchedP1 S{(const char*)C.out, (const char*)(C.ws + WS_WIN), (const char*)(C.ws + WS_MEMN), (const char*)(C.ws + WS_WMEM), G, bid};
        EpiP1 E{(bf16_t*)(C.ws + WS_QS), (bf16_t*)(C.ws + WS_KS), (bf16_t*)(C.ws + WS_VS), (bf16_t*)(C.ws + WS_QR), (bf16_t*)(C.ws + WS_KR), (bf16_t*)(C.ws + WS_VR), (bf16_t*)(C.ws + WS_GR),
                (bf16_t*)(C.ws + WS_QM), (bf16_t*)(C.ws + WS_GT), (bf16_t*)(C.ws + WS_MK), (bf16_t*)(C.ws + WS_MV), C.b_gate, C.out};
        pg8::gemm_phase(lds, DM, S, E, wave);
    }
    SEAM(1);
    if (IN(2)) {
        MKCTX;
        constexpr int N_MEM = 544, N_SWA = 2080, N_RA = 4160;
        for (int u = bid; u < N_MEM + N_SWA + N_RA; u += G) {
            if (u < N_MEM) { if (u < 512) mem_unit(C, lds, u >> 7, (u >> 5) & 3, u & 31, wave); else { const int v = u - 512; mem_unit(C, lds, 4 + (v >> 2), v & 3, 0, wave); } }
            else if (u < N_MEM + N_SWA) { const int v = u - N_MEM; if (v < 2048) swa_unit(C, lds, v >> 9, (v >> 7) & 3, v & 127, wave); else { const int x = v - 2048; swa_unit(C, lds, 4 + (x >> 2), x & 3, 0, wave); } }
            else { const int v = u - N_MEM - N_SWA; if (v < 4096) retA_unit(C, lds, v >> 10, (v >> 7) & 7, v & 127, wave); else { const int x = v - 4096; retA_unit(C, lds, 4 + (x >> 3), x & 7, 0, wave); } }
        }
    }
    SEAM(2);
    if (IN(3)) { MKCTX; ret_scan(C, wave); }
    SEAM(3);
    if (IN(4)) {
        MKCTX;
        {
            const int tid = wave * 64 + lane_id();
            RetCRegs R;
            if (bid < 4160) retC_get(C, bid, tid, R);
            for (int u = bid; u < 4160; u += G) {
                retC_put(lds, tid, R);
                __syncthreads();
                if (u + G < 4160) retC_get(C, u + G, tid, R);
                int sq, h, c; retC_decode(u, sq, h, c);
                retC_unit(C, lds, sq, h, c, wave);
            }
        }
    }
    SEAM(4);
    if (IN(5)) {
        MKCTX;
        SchedMerge S{(const char*)(C.ws + WS_QS), (const char*)(C.ws + WS_QR), (const char*)(C.ws + WS_QM), (const char*)(C.ws + WS_WBR), G, bid};
        EpiMerge E{(const bf16_t*)(C.ws + WS_GT), (bf16_t*)(C.ws + WS_MERGED), C.out, (bf16_t*)(C.ws + WS_GR) + (size_t)bid * 65536};
        pg8::gemm_phase(lds, 1024, S, E, wave);
    }
    SEAM(5);
    if (IN(6)) {
        MKCTX;
        conv_merged_s(C, wave);
        SchedSplit<4> S{(const char*)(C.ws + WS_MERGED), (const char*)(C.ws + WS_WO), G, bid, DM, (const unsigned*)(C.ws + WS_BAR + 256), (unsigned)MS, DM};
        EpiWo E{C.xp, C.out, (bf16_t*)(C.ws + WS_H1B), (float*)(C.ws + WS_CTL)};
        pg8::gemm_phase(lds, DM, S, E, wave);
    }
    SEAM(6);
    if (IN(7)) {
        MKCTX;
        conv_h_s(C, wave);
        SchedSimple S{(const char*)(C.ws + WS_H1B), (const char*)(C.ws + WS_WUP), 130, 44, G, bid, (size_t)256 * DM * 2, 32, (const unsigned*)(C.ws + WS_BAR + 512), (unsigned)MS};
        EpiUp E{(const float*)(C.ws + WS_CTL), C.w_conv, C.b_conv, C.sconv, (bf16_t*)(C.ws + WS_ACT), (float*)(C.ws + WS_RAW), C.out, lds + 131072 + 1024};
        pg8::gemm_phase(lds, DM, S, E, wave);
    }
    SEAM(7);
    if (IN(8)) { MKCTX; conv_fixup(C, wave); }
    SEAM(8);
    if (IN(9)) {
        MKCTX;
        SchedSplit<11> S{(const char*)(C.ws + WS_ACT), (const char*)(C.ws + WS_WDN), G, bid, FF, nullptr, 0u, FFP};
        EpiDown E{(float*)(C.ws + WS_VR), (bf16_t*)(C.ws + WS_H1B)};
        pg8::gemm_phase(lds, FFP, S, E, wave);
    }
    SEAM(9);
    if (IN(10)) { MKCTX; final_norm(C, wave); }
    if (pass == 0) SEAM(10);
    }
#undef IN
#undef SEAM
}

extern "C" void kernel_launch(void* const* d_in, const int* in_sizes, int n_in, void* d_out, int out_size, void* d_ws, size_t ws_size, hipStream_t stream) {
    static int grid = 0;
    if (grid == 0) {
        if (n_in != 23 || (size_t)out_size != O_END || ws_size < WS_END) { fprintf(stderr, "kernel_launch: unexpected shapes n_in %d out %d ws %zu\n", n_in, out_size, ws_size); grid = -1; return; }
        int dev = 0, cus = 0, per_cu = 0;
        (void)hipGetDevice(&dev);
        (void)hipDeviceGetAttribute(&cus, hipDeviceAttributeMultiprocessorCount, dev);
        (void)hipFuncSetAttribute((const void*)fwd, hipFuncAttributeMaxDynamicSharedMemorySize, LDS_BYTES);
        (void)hipOccupancyMaxActiveBlocksPerMultiprocessor(&per_cu, (const void*)fwd, 512, LDS_BYTES);
        if (per_cu < 1) per_cu = 1;
        grid = cus * per_cu;
        if (grid != 256) { fprintf(stderr, "kernel_launch: this kernel is laid out for 256 workgroups (one per CU); got %d\n", grid); grid = -1; return; }
    }
    if (grid < 0) return;
    (void)hipMemsetAsync((char*)d_ws + WS_XBAR, 0, XCD_BAR_WORDS * 4, stream);
    Args a{};
    for (int i = 0; i < 23; ++i) a.in[i] = (const float*)d_in[i];
    a.out = (float*)d_out; a.ws = (unsigned char*)d_ws; a.ph_lo = 0; a.ph_hi = 11;
    void* args[] = {&a};
    hipError_t e = hipLaunchCooperativeKernel((const void*)fwd, dim3(grid), dim3(512), args, LDS_BYTES, stream);
    if (e != hipSuccess) fprintf(stderr, "cooperative launch failed: %s (grid %d)\n", hipGetErrorString(e), grid);
}
```

```cpp
#include <hip/hip_runtime.h>
#include <hip/hip_cooperative_groups.h>
#include <cstdio>
#include <cstdint>
namespace cg = cooperative_groups;

#define DI __device__ __forceinline__
#define LAS __attribute__((address_space(3)))
typedef unsigned short bf16_t;
typedef short bf16x8 __attribute__((ext_vector_type(8)));
typedef short s16x4 __attribute__((ext_vector_type(4)));
typedef float f32x4 __attribute__((ext_vector_type(4)));
typedef float f32x16 __attribute__((ext_vector_type(16)));
typedef unsigned u32x4 __attribute__((ext_vector_type(4)));
typedef unsigned u32x2 __attribute__((ext_vector_type(2)));
typedef float f32x2_t __attribute__((ext_vector_type(2)));
typedef __bf16 bf16x2_t __attribute__((ext_vector_type(2)));

constexpr int MP = 32768, MS = 512, MT = MP + MS;
constexpr int DM = 2048, NIN = 12800, FF = 5632, FF2 = 11264;
constexpr int FFP = 5696;
constexpr float EPS = 1e-6f;
constexpr float LOG2E = 1.4426950408889634f;

constexpr size_t MiB = 1u << 20;
constexpr size_t WS_BAR = 512 * 1024;
constexpr size_t WS_CTL = 0;
constexpr size_t WS_WIN = 1 * MiB;
constexpr size_t WS_WBR = 51 * MiB;
constexpr size_t WS_WO = 63 * MiB;
constexpr size_t WS_WMEM = 71 * MiB;
constexpr size_t WS_WUP = 79 * MiB;
constexpr size_t WS_WDN = 983 * MiB;
constexpr size_t WS_QS = 145 * MiB, WS_QR = 210 * MiB, WS_QM = 275 * MiB, WS_KR = 340 * MiB, WS_VR = 405 * MiB, WS_GR = 470 * MiB;
constexpr size_t WS_KS = 535 * MiB, WS_VS = WS_KS + (size_t)MT * 256 * 2;
constexpr size_t WS_GT = WS_VS + (size_t)MT * 256 * 2;
constexpr size_t WS_MK = WS_GT + (size_t)MT * 6144 * 2, WS_MV = WS_MK + 6 * MiB;
constexpr size_t WS_MEMN = WS_MV + 6 * MiB;
constexpr size_t WS_S0T = WS_MEMN + 4 * MiB;
constexpr size_t WS_MS32 = WS_S0T + 2 * MiB;
constexpr size_t WS_END = WS_MS32 + 4 * MiB;
constexpr size_t WS_MERGED = WS_KR;
constexpr size_t WS_H1B = WS_QS;
constexpr size_t WS_ACT = WS_GT;
constexpr size_t WS_RAW = WS_QM;
static_assert(WS_END <= 983 * MiB && WS_WDN + (size_t)2048 * 5696 * 2 <= 1024 * MiB, "ws map");
static_assert(WS_RAW + (size_t)128 * 4 * 4 * 2 * FF * 4 <= WS_VR, "raw rows");

constexpr size_t O_Y = 0;
constexpr size_t O_SWAK_P = (size_t)MT * DM, O_SWAV_P = O_SWAK_P + 131072, O_RET_P = O_SWAV_P + 131072, O_CONV_P = O_RET_P + 524288,
                 O_MEMK = O_CONV_P + 90112, O_MEMV = O_MEMK + 1048576, O_SWAK_S = O_MEMV + 1048576, O_SWAV_S = O_SWAK_S + 262144,
                 O_RET_S = O_SWAV_S + 262144, O_CONV_S = O_RET_S + 1048576, O_END = O_CONV_S + 180224;

struct Args {
    const float* in[23]; float* out; unsigned char* ws; int ph_lo, ph_hi;
};

struct Ctx {
    const float *xp, *xs, *memp, *cswak, *cswav, *sret, *sconv, *cmemk, *cmemv, *g_mix, *w_in, *b_gate, *sink, *w_br, *w_o, *g_mem, *w_mem, *g_ffn, *w_up, *w_conv, *b_conv, *w_down, *g_final;
    float* out; unsigned char* ws;
};

DI int lane_id() { int l; asm volatile("v_mbcnt_lo_u32_b32 %0, -1, 0\n\tv_mbcnt_hi_u32_b32 %0, -1, %0" : "=v"(l)); return l; }
DI unsigned cvtpk(float lo, float hi) { f32x2_t v = {lo, hi}; bf16x2_t b = __builtin_convertvector(v, bf16x2_t); return __builtin_bit_cast(unsigned, b); }
DI float bf2f(unsigned short h) { return __uint_as_float((unsigned)h << 16); }
DI float bflo(unsigned w) { return __uint_as_float(w << 16); }
DI float bfhi(unsigned w) { return __uint_as_float(w & 0xffff0000u); }
DI float fexp2(float x) { return __builtin_amdgcn_exp2f(x); }
DI float frcp(float x) { return __builtin_amdgcn_rcpf(x); }
DI float silu_f(float x) { return x * frcp(1.f + fexp2(-x * LOG2E)); }
DI float sigm_f(float x) { return frcp(1.f + fexp2(-x * LOG2E)); }
DI float wave_sum(float v) {
#pragma unroll
    for (int o = 1; o < 64; o <<= 1) v += __shfl_xor(v, o);
    return v;
}
DI float log2gamma(int h) { const float x = fexp2(-5.f - (float)h); return -x * (1.f + x * (0.5f + x * (0.33333334f + x * (0.25f + x * (0.2f + x * 0.16666667f))))) * LOG2E; }

namespace pg8 {
constexpr int BM = 256, BK = 64, HALF = 128, HTB = HALF * BK * 2, STAGE_BYTES = 8 * HTB, NXCD = 8, WGM = 8;
DI int lds_byte(int r, int c) { const int st = (r >> 4) * 2 + (c >> 5), rr = r & 15, cc = c & 31, ob = rr * 64 + cc * 2; return st * 1024 + (ob ^ (((ob >> 9) & 1) << 5)); }
DI void stage_rc(int b, int& R, int& C) { const int st = b / 1024, sb = b % 1024, swz = sb ^ (((sb >> 9) & 1) << 5); R = (st >> 1) * 16 + swz / 64; C = (st & 1) * 32 + (swz % 64) / 2; }
DI int perm32(int rho) { const int n = rho >> 4, i = rho & 15; return 8 * (i >> 2) + 4 * n + (i & 3); }
struct Unit { int pm, pn, z, nt, kp; };
DI void tile_map(int L, int nM, int nN, int& pm, int& pn) {
    const int nwg = nM * nN; int wgid = L;
    { const int q = nwg / NXCD, r = nwg % NXCD, xcd = wgid % NXCD, off = wgid / NXCD; wgid = (xcd < r ? xcd * (q + 1) : r * (q + 1) + (xcd - r) * q) + off; }
    const int nig = WGM * nN, gid = wgid / nig, fm = gid * WGM, gsz = (nM - fm) < WGM ? (nM - fm) : WGM;
    pm = fm + ((wgid % nig) % gsz); pn = (wgid % nig) / gsz;
}
template <class Epi, class Sched>
DI void gemm_phase(LAS unsigned char* lds, const int K, const Sched& S, const Epi& E, const int wid) {
    const int lane = lane_id(), tid = wid * 64 + lane, wr = wid >> 2, wc = wid & 3, fr = lane & 15, fq = lane >> 4;
    unsigned voffA[2], voffB[2];
#pragma unroll
    for (int i = 0; i < 2; ++i) { int R, C; stage_rc(tid * 16 + i * 8192, R, C); const int Rb = (R & ~31) + perm32(R & 31);
        voffA[i] = (unsigned)(R * K + C) * 2u; voffB[i] = (unsigned)(Rb * K + C) * 2u; }
    const size_t kstep = (size_t)(BK * 2);
    const size_t hstep = (size_t)HALF * K * 2;
    const unsigned ldsw = (unsigned)wid * 1024u;
    const int aoff = lds_byte(wr * 64 + fr, fq * 8), boff = lds_byte(wc * 32 + fr, fq * 8);
#define PG8_SA(b, h) (((b) * 2 + (h)) * HTB)
#define PG8_SB(b, h) ((4 + (b) * 2 + (h)) * HTB)
#define PG8_STAGE(bufoff, gbase, voff) do { _Pragma("unroll") for (int _i = 0; _i < 2; ++_i) \
        __builtin_amdgcn_global_load_lds((const unsigned*)((const char*)(gbase) + (voff)[_i]), (LAS unsigned*)(lds + (bufoff) + ldsw + _i * 8192), 16, 0, 0); } while (0)
#define PG8_LDA(dst, b, h) do { _Pragma("unroll") for (int m = 0; m < 4; ++m) _Pragma("unroll") for (int k = 0; k < 2; ++k) dst[m][k] = *(const LAS bf16x8*)(lds + PG8_SA(b, h) + aoff + m * 2048 + k * 1024); } while (0)
#define PG8_LDB(dst, b, h) do { _Pragma("unroll") for (int n = 0; n < 2; ++n) _Pragma("unroll") for (int k = 0; k < 2; ++k) dst[n][k] = *(const LAS bf16x8*)(lds + PG8_SB(b, h) + boff + n * 2048 + k * 1024); } while (0)
#define PG8_MMA(ai, bj, At, Bt) do { __builtin_amdgcn_s_setprio(1); _Pragma("unroll") for (int m = 0; m < 4; ++m) _Pragma("unroll") for (int n = 0; n < 2; ++n) _Pragma("unroll") for (int k = 0; k < 2; ++k) \
        acc[ai][bj][m][n] = __builtin_amdgcn_mfma_f32_16x16x32_bf16(Bt[n][k], At[m][k], acc[ai][bj][m][n], 0, 0, 0); __builtin_amdgcn_s_setprio(0); } while (0)
#define PG8_WAIT_V(n) asm volatile("s_waitcnt vmcnt(" #n ")" ::: "memory")
#define PG8_WAIT_L(n) asm volatile("s_waitcnt lgkmcnt(" #n ")" ::: "memory")
#define PG8_BAR __builtin_amdgcn_s_barrier()
#define PG8_SCHED __builtin_amdgcn_sched_barrier(0)
    Unit cur, nxt; int ui = 0;
    if (!S.next(0, cur)) return;
    f32x4 acc[2][2][4][2];
#pragma unroll
    for (int a = 0; a < 2; ++a)
#pragma unroll
        for (int b = 0; b < 2; ++b)
#pragma unroll
            for (int m = 0; m < 4; ++m)
#pragma unroll
                for (int n = 0; n < 2; ++n) acc[a][b][m][n] = (f32x4){0.f, 0.f, 0.f, 0.f};
    bf16x8 At[4][2], B0[2][2], B1[2][2];
    S.a_ready(cur);
    const char* cA = S.aptr(cur); const char* cB = S.bptr(cur);
    PG8_STAGE(PG8_SB(0, 0), cB, voffB); PG8_STAGE(PG8_SB(0, 1), cB + hstep, voffB); PG8_STAGE(PG8_SA(0, 0), cA, voffA); PG8_STAGE(PG8_SA(0, 1), cA + hstep, voffA);
    if (wr == 1) PG8_BAR;
    PG8_WAIT_V(2); PG8_BAR;
    PG8_STAGE(PG8_SB(1, 0), cB + kstep, voffB); PG8_STAGE(PG8_SA(1, 0), cA + kstep, voffA); PG8_STAGE(PG8_SB(1, 1), cB + hstep + kstep, voffB);
    PG8_WAIT_V(6); PG8_BAR;
    for (;;) {
        const bool has_next = S.next(ui + 1, nxt);
        const int nt = cur.nt;
        const char* nA = has_next ? S.aptr(nxt) : cA; const char* nB = has_next ? S.bptr(nxt) : cB;
        for (int t = 0; t < nt; t += 2) {
            const bool last = (t == nt - 2);
            const char* a1 = cA + (size_t)(t + 1) * kstep;
            const char* a2 = last ? nA : cA + (size_t)(t + 2) * kstep; const char* b2 = last ? nB : cB + (size_t)(t + 2) * kstep;
            const char* a3 = a2 + kstep; const char* b3 = b2 + kstep;
            if (last && has_next) S.a_ready(nxt);
            PG8_LDB(B0, 0, 0); PG8_LDB(B1, 0, 1); PG8_SCHED; PG8_LDA(At, 0, 0); PG8_STAGE(PG8_SA(1, 1), a1 + hstep, voffA);
            PG8_WAIT_V(8); PG8_WAIT_L(0); PG8_BAR; PG8_MMA(0, 0, At, B0); PG8_MMA(0, 1, At, B1); PG8_BAR; PG8_SCHED;
            PG8_LDA(At, 0, 1); PG8_STAGE(PG8_SB(0, 0), b2, voffB); PG8_STAGE(PG8_SB(0, 1), b2 + hstep, voffB); PG8_STAGE(PG8_SA(0, 0), a2, voffA);
            PG8_WAIT_V(8); PG8_WAIT_L(0); PG8_BAR; PG8_MMA(1, 0, At, B0); PG8_MMA(1, 1, At, B1); PG8_BAR; PG8_SCHED;
            PG8_LDB(B0, 1, 0); PG8_LDB(B1, 1, 1); PG8_SCHED; PG8_LDA(At, 1, 0); PG8_STAGE(PG8_SA(0, 1), a2 + hstep, voffA);
            PG8_WAIT_V(8); PG8_WAIT_L(0); PG8_BAR; PG8_MMA(0, 0, At, B0); PG8_MMA(0, 1, At, B1); PG8_BAR; PG8_SCHED;
            PG8_LDA(At, 1, 1); PG8_STAGE(PG8_SB(1, 0), b3, voffB); PG8_STAGE(PG8_SB(1, 1), b3 + hstep, voffB); PG8_STAGE(PG8_SA(1, 0), a3, voffA);
            PG8_WAIT_V(8); PG8_WAIT_L(0); PG8_BAR; PG8_MMA(1, 0, At, B0); PG8_MMA(1, 1, At, B1); PG8_BAR; PG8_SCHED;
        }
        if (wr == 0) PG8_BAR;
        E(acc, cur, wr, wc, fr, fq);
        if (!has_next) break;
#pragma unroll
        for (int a = 0; a < 2; ++a)
#pragma unroll
            for (int b = 0; b < 2; ++b)
#pragma unroll
                for (int m = 0; m < 4; ++m)
#pragma unroll
                    for (int n = 0; n < 2; ++n) acc[a][b][m][n] = (f32x4){0.f, 0.f, 0.f, 0.f};
        cur = nxt; cA = nA; cB = nB; ++ui;
        if (wr == 1) PG8_BAR;
    }
    PG8_WAIT_V(0);
    PG8_BAR;
#undef PG8_SA
#undef PG8_SB
#undef PG8_STAGE
#undef PG8_LDA
#undef PG8_LDB
#undef PG8_MMA
#undef PG8_WAIT_V
#undef PG8_WAIT_L
#undef PG8_BAR
#undef PG8_SCHED
}
}
using pg8::Unit;
typedef f32x4 Acc[2][2][4][2];

DI void store8bf(bf16_t* p, f32x4 a, f32x4 b) { u32x4 w; w.x = cvtpk(a[0], a[1]); w.y = cvtpk(a[2], a[3]); w.z = cvtpk(b[0], b[1]); w.w = cvtpk(b[2], b[3]); *(u32x4*)p = w; }

DI void wait_counter(const unsigned* ctr, unsigned target) {
    while (__hip_atomic_load(ctr, __ATOMIC_RELAXED, __HIP_MEMORY_SCOPE_AGENT) < target) __builtin_amdgcn_s_sleep(2);
    __builtin_amdgcn_fence(__ATOMIC_ACQUIRE, "agent");
}
struct SchedSimple {
    const char *A, *B; int nM, nN, G, c; size_t tstep; int ntk; const unsigned* ctr; unsigned target;
    DI bool next(int i, Unit& u) const { const long L = (long)i * G + c; if (L >= (long)nM * nN) return false; pg8::tile_map((int)L, nM, nN, u.pm, u.pn); u.z = 0; u.nt = ntk; u.kp = -1; return true; }
    DI const char* aptr(const Unit& u) const { return A + (size_t)u.pm * tstep; }
    DI const char* bptr(const Unit& u) const { return B + (size_t)u.pn * tstep; }
    DI void a_ready(const Unit& u) const { if (ctr && u.pm >= 128) wait_counter(ctr, target); }
};
struct SchedP1 {
    const char *A, *B, *A2, *B2; int G, c;
    DI bool next(int i, Unit& u) const { long L = (long)i * G + c; u.nt = 32; u.kp = -1; if (L < 130 * 50) { pg8::tile_map((int)L, 130, 50, u.pm, u.pn); u.z = 0; return true; }
        L -= 130 * 50; if (L < 32) { u.pm = (int)(L >> 3); u.pn = (int)(L & 7); u.z = 1; return true; } return false; }
    DI const char* aptr(const Unit& u) const { return (u.z ? A2 : A) + (size_t)u.pm * (256 * 2048 * 2); }
    DI const char* bptr(const Unit& u) const { return (u.z ? B2 : B) + (size_t)u.pn * (256 * 2048 * 2); }
    DI void a_ready(const Unit&) const {}
};
template <int NP>
struct SchedSplit {
    const char *A, *B; int G, c; int K; const unsigned* ctr; unsigned target; int pitch;
    DI bool next(int i, Unit& u) const {
        const int L = i * G + c; int pm, pn, nt, kp; bool ok = true;
        if (L < 1024) { pg8::tile_map(L, 128, 8, pm, pn); nt = K / 64; kp = -1; }
        else { const int P = L - 1024, tile = P / NP; kp = P % NP; pm = 128 + (tile >> 3); pn = tile & 7; nt = 8; ok = P < 16 * NP; }
        u.pm = pm; u.pn = pn; u.z = 0; u.nt = nt; u.kp = kp; return ok; }
    DI const char* aptr(const Unit& u) const { return A + ((size_t)u.pm * 256 * pitch + (u.kp > 0 ? u.kp * 512 : 0)) * 2; }
    DI const char* bptr(const Unit& u) const { return B + ((size_t)u.pn * 256 * pitch + (u.kp > 0 ? u.kp * 512 : 0)) * 2; }
    DI void a_ready(const Unit& u) const { if (ctr && u.pm >= 128) wait_counter(ctr, target); }
};
struct SchedMerge {
    const char *A0, *A1, *A2, *B; int G, c;
    DI bool next(int i, Unit& u) const {
        int pm, pn, z, nt, kp; bool ok = true;
        if (i < 12) { pg8::tile_map((i / 3) * 256 + c, 128, 8, pm, pn); z = i % 3; nt = 16; kp = -1; }
        else { const int L = (i - 12) * 256 + c, tile = L / 6, rem = L % 6; pm = 128 + (tile >> 3); pn = tile & 7; z = rem >> 1; kp = rem & 1; nt = 8; ok = L < 96; }
        u.pm = pm; u.pn = pn; u.z = z; u.nt = nt; u.kp = kp; return ok; }
    DI const char* aptr(const Unit& u) const { return (u.z == 0 ? A0 : (u.z == 1 ? A1 : A2)) + ((size_t)u.pm * 256 * 1024 + (u.kp > 0 ? 512 : 0)) * 2; }
    DI const char* bptr(const Unit& u) const { return B + (((size_t)u.z * 2048 + (size_t)u.pn * 256) * 1024 + (u.kp > 0 ? 512 : 0)) * 2; }
    DI void a_ready(const Unit&) const {}
};

struct EpiP1 {
    bf16_t *QS, *KS, *VS, *QR, *KR, *VR, *GR, *QM, *GT, *MK, *MV; const float* b_gate; float* out;
    DI void plain(const Acc& acc, bf16_t* O, int ld, int col0, int row0, float sc, int act) const {
#pragma unroll
        for (int ai = 0; ai < 2; ++ai)
#pragma unroll
            for (int m = 0; m < 4; ++m) { bf16_t* rowp = O + (size_t)(row0 + ai * 128 + m * 16) * ld + col0;
#pragma unroll
                for (int bj = 0; bj < 2; ++bj) { f32x4 v0 = acc[ai][bj][m][0] * sc, v1 = acc[ai][bj][m][1] * sc;
                    if (act == 1) {
#pragma unroll
                        for (int j = 0; j < 4; ++j) { v0[j] = silu_f(v0[j]); v1[j] = silu_f(v1[j]); } }
                    store8bf(rowp + bj * 128, v0, v1); } }
    }
    DI void operator()(const Acc& acc, const Unit& u, int wr, int wc, int fr, int fq) const {
        asm volatile("" : "+v"(fr), "+v"(fq));
        const int row0 = u.pm * 256 + wr * 64 + fr, cl = wc * 32 + 8 * fq;
        if (u.z == 1) {
            bf16_t* Ob = (u.pn < 4) ? MK : MV; float* Of = out + ((u.pn < 4) ? O_MEMK : O_MEMV); const int c0 = (u.pn & 3) * 256 + cl;
#pragma unroll
            for (int ai = 0; ai < 2; ++ai)
#pragma unroll
                for (int m = 0; m < 4; ++m) { const size_t r = (size_t)(row0 + ai * 128 + m * 16);
#pragma unroll
                    for (int bj = 0; bj < 2; ++bj) { store8bf(Ob + r * 1024 + c0 + bj * 128, acc[ai][bj][m][0], acc[ai][bj][m][1]);
                        *(f32x4*)(Of + r * 1024 + c0 + bj * 128) = acc[ai][bj][m][0]; *(f32x4*)(Of + r * 1024 + c0 + bj * 128 + 4) = acc[ai][bj][m][1]; } }
            return;
        }
        const int pn = u.pn;
        if (pn < 4) { plain(acc, QS, 1024, pn * 256 + cl, row0, 0.125f * LOG2E, 0); return; }
        if (pn < 6) {
            bf16_t* O = (pn == 4) ? KS : VS; plain(acc, O, 256, cl, row0, 1.f, 0);
            if (u.pm >= 128) {
                float* Of = out + ((pn == 4) ? O_SWAK_S : O_SWAV_S);
#pragma unroll
                for (int ai = 0; ai < 2; ++ai) { const int b = (u.pm - 128) * 4 + 2 * ai + wr;
#pragma unroll
                    for (int m = 0; m < 4; ++m) { float* rp = Of + ((size_t)b * 128 + 64 + 16 * m + fr) * 256 + cl;
#pragma unroll
                        for (int bj = 0; bj < 2; ++bj) { *(f32x4*)(rp + bj * 128) = acc[ai][bj][m][0]; *(f32x4*)(rp + bj * 128 + 4) = acc[ai][bj][m][1]; } } }
            } else if ((u.pm & 31) == 31) {
                float* Of = out + ((pn == 4) ? O_SWAK_P : O_SWAV_P); const int b = u.pm >> 5;
#pragma unroll
                for (int m = 0; m < 4; ++m) { float* rp = Of + ((size_t)b * 128 + 64 * wr + 16 * m + fr) * 256 + cl;
#pragma unroll
                    for (int bj = 0; bj < 2; ++bj) { *(f32x4*)(rp + bj * 128) = acc[1][bj][m][0]; *(f32x4*)(rp + bj * 128 + 4) = acc[1][bj][m][1]; } }
            }
            return;
        }
        if (pn < 14) {
            const bool isq = pn < 10; bf16_t* O = isq ? QR : KR; const int hb = 2 * (pn - (isq ? 6 : 10));
            const int i0 = 16 * wc + 4 * fq; float invf[4];
#pragma unroll
            for (int j = 0; j < 4; ++j) invf[j] = fexp2(-(float)(i0 + j) * (13.287712379549449f / 63.0f));
            const float lg0 = log2gamma(hb), lg1 = log2gamma(hb + 1);
#pragma unroll
            for (int ai = 0; ai < 2; ++ai)
#pragma unroll
                for (int m = 0; m < 4; ++m) {
                    const int row = row0 + ai * 128 + m * 16; const int nl = 16 * m + fr;
                    const float pos = (u.pm >= 128) ? (float)(1024 + nl) : (float)(row & 8191);
                    float cs[4], sn[4];
#pragma unroll
                    for (int j = 0; j < 4; ++j) { float rev = (pos * invf[j]) * 0.15915494309189535f; rev = rev - floorf(rev); cs[j] = __builtin_amdgcn_cosf(rev); sn[j] = __builtin_amdgcn_sinf(rev); }
#pragma unroll
                    for (int bj = 0; bj < 2; ++bj) {
                        const float e = (float)(nl + 1) * (bj ? lg1 : lg0);
                        const float sc = isq ? fexp2(e) : 0.08838834764831845f * fexp2(-e);
                        const f32x4 x1 = acc[ai][bj][m][0], x2 = acc[ai][bj][m][1]; f32x4 o1, o2;
#pragma unroll
                        for (int j = 0; j < 4; ++j) { o1[j] = (x1[j] * cs[j] - x2[j] * sn[j]) * sc; o2[j] = (x1[j] * sn[j] + x2[j] * cs[j]) * sc; }
                        store8bf(O + (size_t)row * 1024 + (hb + bj) * 128 + cl, o1, o2);
                    }
                }
            return;
        }
        if (pn < 18) { plain(acc, VR, 1024, (pn - 14) * 256 + cl, row0, 1.f, 0); return; }
        if (pn < 22) { plain(acc, GR, 1024, (pn - 18) * 256 + cl, row0, 1.f, 1); return; }
        if (pn < 26) { plain(acc, QM, 1024, (pn - 22) * 256 + cl, row0, 0.0625f * LOG2E, 0); return; }
        {
            const int c0 = (pn - 26) * 256 + cl; f32x4 bv[2][2];
#pragma unroll
            for (int bj = 0; bj < 2; ++bj)
#pragma unroll
                for (int n = 0; n < 2; ++n) bv[bj][n] = *(const f32x4*)(b_gate + c0 + bj * 128 + 4 * n);
#pragma unroll
            for (int ai = 0; ai < 2; ++ai)
#pragma unroll
                for (int m = 0; m < 4; ++m) {
                    u32x4 qw;
#pragma unroll
                    for (int bj = 0; bj < 2; ++bj) { f32x4 v0 = acc[ai][bj][m][0] + bv[bj][0], v1 = acc[ai][bj][m][1] + bv[bj][1];
#pragma unroll
                        for (int j = 0; j < 4; ++j) { v0[j] = sigm_f(v0[j]); v1[j] = sigm_f(v1[j]); }
                        const unsigned lo = (unsigned)(v0[0] * 255.f + 0.5f) | ((unsigned)(v0[1] * 255.f + 0.5f) << 8) | ((unsigned)(v0[2] * 255.f + 0.5f) << 16) | ((unsigned)(v0[3] * 255.f + 0.5f) << 24);
                        const unsigned hi = (unsigned)(v1[0] * 255.f + 0.5f) | ((unsigned)(v1[1] * 255.f + 0.5f) << 8) | ((unsigned)(v1[2] * 255.f + 0.5f) << 16) | ((unsigned)(v1[3] * 255.f + 0.5f) << 24);
                        if (bj == 0) { qw.x = lo; qw.y = hi; } else { qw.z = lo; qw.w = hi; } }
                    *(u32x4*)((unsigned char*)GT + ((size_t)u.pm * 24 + (pn - 26)) * 65536 + ((size_t)(((wr * 4 + wc) * 8 + ai * 4 + m) * 64 + fq * 16 + fr)) * 16) = qw; }
        }
    }
};

DI float gq(unsigned w, int j) { return (float)((w >> (8 * j)) & 255u) * (1.0f / 255.0f); }
struct EpiMerge {
    const bf16_t* GT; bf16_t* MG; float* MS32; bf16_t* T;
    DI void operator()(const Acc& acc, const Unit& u, int wr, int wc, int fr, int fq) const {
        asm volatile("" : "+v"(fr), "+v"(fq));
        const int row0 = u.pm * 256 + wr * 64 + fr, c0 = u.pn * 256 + wc * 32 + 8 * fq;
        bf16_t* Tp = T + ((size_t)((wr * 4 + wc) * 16) * 64 + fq * 16 + fr) * 8;
        if (u.kp >= 0) {
            float* P = MS32 + (size_t)(u.z * 2 + u.kp) * MS * DM;
#pragma unroll
            for (int ai = 0; ai < 2; ++ai) {
                u32x2 g[4][2];
#pragma unroll
                for (int m = 0; m < 4; ++m) { const u32x4 gw = *(const u32x4*)((const unsigned char*)GT + ((size_t)u.pm * 24 + u.z * 8 + u.pn) * 65536 + ((size_t)(((wr * 4 + wc) * 8 + ai * 4 + m) * 64 + fq * 16 + fr)) * 16); g[m][0] = (u32x2){gw.x, gw.y}; g[m][1] = (u32x2){gw.z, gw.w}; }
#pragma unroll
                for (int m = 0; m < 4; ++m)
#pragma unroll
                    for (int bj = 0; bj < 2; ++bj) { const u32x2 gg = g[m][bj]; float* d = P + (size_t)(row0 - MP + ai * 128 + m * 16) * 2048 + c0 + bj * 128;
                        f32x4 v0 = acc[ai][bj][m][0], v1 = acc[ai][bj][m][1];
                        v0[0] *= gq(gg.x, 0); v0[1] *= gq(gg.x, 1); v0[2] *= gq(gg.x, 2); v0[3] *= gq(gg.x, 3); v1[0] *= gq(gg.y, 0); v1[1] *= gq(gg.y, 1); v1[2] *= gq(gg.y, 2); v1[3] *= gq(gg.y, 3);
                        *(f32x4*)d = v0; *(f32x4*)(d + 4) = v1; }
                asm volatile("" ::: "memory");
            }
            return;
        }
#pragma unroll
        for (int ai = 0; ai < 2; ++ai) {
            u32x2 g[4][2]; u32x4 p[4][2];
#pragma unroll
            for (int m = 0; m < 4; ++m) { const u32x4 gw = *(const u32x4*)((const unsigned char*)GT + ((size_t)u.pm * 24 + u.z * 8 + u.pn) * 65536 + ((size_t)(((wr * 4 + wc) * 8 + ai * 4 + m) * 64 + fq * 16 + fr)) * 16); g[m][0] = (u32x2){gw.x, gw.y}; g[m][1] = (u32x2){gw.z, gw.w}; }
            if (u.z > 0) {
#pragma unroll
                for (int m = 0; m < 4; ++m)
#pragma unroll
                    for (int bj = 0; bj < 2; ++bj) p[m][bj] = *(const u32x4*)(Tp + (size_t)(ai * 8 + m * 2 + bj) * 512);
            } else {
#pragma unroll
                for (int m = 0; m < 4; ++m)
#pragma unroll
                    for (int bj = 0; bj < 2; ++bj) p[m][bj] = (u32x4){0u, 0u, 0u, 0u};
            }
#pragma unroll
            for (int m = 0; m < 4; ++m)
#pragma unroll
                for (int bj = 0; bj < 2; ++bj) {
                    const u32x2 gg = g[m][bj]; const u32x4 pp = p[m][bj];
                    f32x4 v0 = acc[ai][bj][m][0], v1 = acc[ai][bj][m][1];
                    v0[0] = v0[0] * gq(gg.x, 0) + bflo(pp.x); v0[1] = v0[1] * gq(gg.x, 1) + bfhi(pp.x); v0[2] = v0[2] * gq(gg.x, 2) + bflo(pp.y); v0[3] = v0[3] * gq(gg.x, 3) + bfhi(pp.y);
                    v1[0] = v1[0] * gq(gg.y, 0) + bflo(pp.z); v1[1] = v1[1] * gq(gg.y, 1) + bfhi(pp.z); v1[2] = v1[2] * gq(gg.y, 2) + bflo(pp.w); v1[3] = v1[3] * gq(gg.y, 3) + bfhi(pp.w);
                    if (u.z < 2) store8bf(Tp + (size_t)(ai * 8 + m * 2 + bj) * 512, v0, v1);
                    else store8bf(MG + (size_t)(row0 + ai * 128 + m * 16) * 2048 + c0 + bj * 128, v0, v1);
                }
            asm volatile("" ::: "memory");
        }
    }
};

DI void partial_tile(const Acc& acc, float* P, int rows0, int c0) {
#pragma unroll
    for (int ai = 0; ai < 2; ++ai)
#pragma unroll
        for (int m = 0; m < 4; ++m)
#pragma unroll
            for (int bj = 0; bj < 2; ++bj) { float* d = P + (size_t)(rows0 + ai * 128 + m * 16) * DM + c0 + bj * 128; *(f32x4*)d = acc[ai][bj][m][0]; *(f32x4*)(d + 4) = acc[ai][bj][m][1]; }
}
struct EpiWo {
    const float* xp; float* PART; bf16_t* H1B; float* ss1;
    DI void operator()(const Acc& acc, const Unit& u, int wr, int wc, int fr, int fq) const {
        const int row0 = u.pm * 256 + wr * 64 + fr, c0 = u.pn * 256 + wc * 32 + 8 * fq;
        if (u.kp >= 0) { partial_tile(acc, PART + (size_t)u.kp * MS * DM, row0 - MP, c0); return; }
#pragma unroll
        for (int ai = 0; ai < 2; ++ai) {
            f32x4 xv[4][2][2];
#pragma unroll
            for (int m = 0; m < 4; ++m)
#pragma unroll
                for (int bj = 0; bj < 2; ++bj) { const size_t o = (size_t)(row0 + ai * 128 + m * 16) * DM + c0 + bj * 128; xv[m][bj][0] = *(const f32x4*)(xp + o); xv[m][bj][1] = *(const f32x4*)(xp + o + 4); }
#pragma unroll
            for (int m = 0; m < 4; ++m) { const size_t r = (size_t)(row0 + ai * 128 + m * 16); float s = 0.f;
#pragma unroll
                for (int bj = 0; bj < 2; ++bj) { const size_t o = r * DM + c0 + bj * 128;
                    const f32x4 v0 = acc[ai][bj][m][0] + xv[m][bj][0], v1 = acc[ai][bj][m][1] + xv[m][bj][1];
                    store8bf(H1B + o, v0, v1);
                    s += (v0[0] * v0[0] + v0[1] * v0[1]) + (v0[2] * v0[2] + v0[3] * v0[3]) + (v1[0] * v1[0] + v1[1] * v1[1]) + (v1[2] * v1[2] + v1[3] * v1[3]); }
                s += __shfl_xor(s, 16); s += __shfl_xor(s, 32);
                if (fq == 0) atomicAdd(ss1 + r, s); }
            asm volatile("" ::: "memory");
        }
    }
};

struct EpiDown {
    float* PART; bf16_t* H1B;
    DI void operator()(const Acc& acc, const Unit& u, int wr, int wc, int fr, int fq) const {
        const int row0 = u.pm * 256 + wr * 64 + fr, c0 = u.pn * 256 + wc * 32 + 8 * fq;
        if (u.kp >= 0) { partial_tile(acc, PART + (size_t)u.kp * MS * DM, row0 - MP, c0); return; }
#pragma unroll
        for (int ai = 0; ai < 2; ++ai) {
            u32x4 hv[4][2];
#pragma unroll
            for (int m = 0; m < 4; ++m)
#pragma unroll
                for (int bj = 0; bj < 2; ++bj) hv[m][bj] = *(const u32x4*)(H1B + (size_t)(row0 + ai * 128 + m * 16) * DM + c0 + bj * 128);
#pragma unroll
            for (int m = 0; m < 4; ++m)
#pragma unroll
                for (int bj = 0; bj < 2; ++bj) { const u32x4 h = hv[m][bj]; f32x4 v0 = acc[ai][bj][m][0], v1 = acc[ai][bj][m][1];
                    v0[0] += bflo(h.x); v0[1] += bfhi(h.x); v0[2] += bflo(h.y); v0[3] += bfhi(h.y); v1[0] += bflo(h.z); v1[1] += bfhi(h.z); v1[2] += bflo(h.w); v1[3] += bfhi(h.w);
                    store8bf(H1B + (size_t)(row0 + ai * 128 + m * 16) * DM + c0 + bj * 128, v0, v1); }
            asm volatile("" ::: "memory");
        }
    }
};

template <int CTRL> DI float dpp_ror(float v) { return __builtin_bit_cast(float, __builtin_amdgcn_update_dpp(0, __builtin_bit_cast(int, v), CTRL, 0xf, 0xf, false)); }

struct EpiUp {
    const float *ss1, *w_conv, *b_conv, *sconv; bf16_t* ACT; float* RAW; float* out; LAS unsigned char* xl;
    template <int GV>
    DI void conv_cols(const Acc& acc, const Unit& u, int ai, int n, int G, int f, int fr, const float (&rs)[4], bool samp, int sb, const f32x4 (&cw)[4], f32x4 (&cg)[4], bf16_t* actp) const {
        f32x4 X[4];
#pragma unroll
        for (int m = 0; m < 4; ++m) X[m] = acc[ai][GV][m][n] * rs[m];
        f32x4 Hh = (f32x4){0.f, 0.f, 0.f, 0.f};
        if (samp) { if (fr >= 14) Hh = *(const f32x4*)(sconv + ((size_t)sb * 2 + (fr - 14)) * FF2 + GV * FF + f); }
        else {
            float* rw = RAW + ((((size_t)u.pm * 4 + G) * 4) * 2 + GV) * FF + f;
            if (fr < 2 || fr >= 14) *(f32x4*)(rw + (size_t)(fr < 2 ? fr : fr - 12) * 2 * FF) = (fr < 2) ? X[0] : X[3];
        }
        if (fr >= 14) {
            if (samp) *(f32x4*)(out + O_CONV_S + ((size_t)sb * 2 + (fr - 14)) * FF2 + GV * FF + f) = X[3];
            else if ((u.pm & 31) == 31 && G == 3) *(f32x4*)(out + O_CONV_P + ((size_t)(u.pm >> 5) * 2 + (fr - 14)) * FF2 + GV * FF + f) = X[3];
        }
#pragma unroll
        for (int m = 0; m < 4; ++m) {
            f32x4 p1, p2;
#pragma unroll
            for (int j = 0; j < 4; ++j) {
                const float prev = (m == 0) ? Hh[j] : X[m - 1][j];
                const float a1 = dpp_ror<0x121>(X[m][j]), b1 = dpp_ror<0x121>(prev);
                const float a2 = dpp_ror<0x122>(X[m][j]), b2 = dpp_ror<0x122>(prev);
                p1[j] = (fr >= 1) ? a1 : b1; p2[j] = (fr >= 2) ? a2 : b2;
            }
            const f32x4 c = cw[3] + cw[0] * p2 + cw[1] * p1 + cw[2] * X[m];
            if (GV == 0) cg[m] = c;
            else { u32x2 wv; wv.x = cvtpk(silu_f(cg[m][0]) * c[0], silu_f(cg[m][1]) * c[1]); wv.y = cvtpk(silu_f(cg[m][2]) * c[2], silu_f(cg[m][3]) * c[3]);
                *(u32x2*)(actp + (size_t)(m * 16) * FFP) = wv; }
        }
    }
    DI void operator()(const Acc& acc, const Unit& u, int wr, int wc, int fr, int fq) const {
        asm volatile("" : "+v"(fr), "+v"(fq));
        const int row0 = u.pm * 256 + wr * 64 + fr; const int f0 = u.pn * 128 + wc * 32 + 8 * fq; const bool samp = u.pm >= 128;
        {
            const int t = (wr * 4 + wc) * 64 + fq * 16 + fr;
            LAS float* cwl = (LAS float*)xl; LAS float* ssl = cwl + 1024;
            if (t < 256) { const int q = t >> 5, f4 = (t & 31) * 4, gv = q >> 2, tap = q & 3;
                *(LAS f32x4*)(cwl + q * 128 + f4) = *(const f32x4*)((tap < 3 ? w_conv + (size_t)tap * FF2 : b_conv) + gv * FF + u.pn * 128 + f4); }
            else if (t < 320) *(LAS f32x4*)(ssl + (t - 256) * 4) = *(const f32x4*)(ss1 + (size_t)u.pm * 256 + (t - 256) * 4);
            asm volatile("s_waitcnt lgkmcnt(0)" ::: "memory");
            __builtin_amdgcn_s_barrier();
            asm volatile("" ::: "memory");
        }
        const LAS float* cwl = (const LAS float*)xl; const LAS float* ssl = cwl + 1024;
        float rs[2][4];
#pragma unroll
        for (int ai = 0; ai < 2; ++ai)
#pragma unroll
            for (int m = 0; m < 4; ++m) rs[ai][m] = rsqrtf(ssl[wr * 64 + fr + ai * 128 + m * 16] * (1.0f / DM) + EPS);
#pragma unroll
        for (int n = 0; n < 2; ++n) {
            const int f = f0 + 4 * n; const int fl = wc * 32 + 8 * fq + 4 * n;
            f32x4 cwg[4], cwv[4];
#pragma unroll
            for (int t = 0; t < 4; ++t) { cwg[t] = *(const LAS f32x4*)(cwl + t * 128 + fl); cwv[t] = *(const LAS f32x4*)(cwl + (4 + t) * 128 + fl); }
#pragma unroll
            for (int ai = 0; ai < 2; ++ai) {
                const int G = 2 * ai + wr; const int sb = (u.pm - 128) * 4 + G;
                f32x4 cg[4];
                conv_cols<0>(acc, u, ai, n, G, f, fr, rs[ai], samp, sb, cwg, cg, nullptr);
                conv_cols<1>(acc, u, ai, n, G, f, fr, rs[ai], samp, sb, cwv, cg, ACT + (size_t)(row0 + ai * 128) * FFP + f);
            }
            asm volatile("" ::: "memory");
        }
    }
};

DI int dest_row(int mode, int n) {
    if (mode == 1) { if (n >= 1536 && n < 3584) { const int hd = (n - 1536) >> 7, d = (n - 1536) & 127, half = d >> 6, i = d & 63; return 1536 + hd * 128 + 8 * (i >> 2) + 4 * half + (i & 3); } return n; }
    if (mode == 2) { const int gv = n >= FF ? 1 : 0, f = n - gv * FF; return 256 * (f >> 7) + 128 * gv + (f & 127); }
    return n;
}
DI void p0_transpose_item(const float* W, int K, int N, bf16_t* WT, int mode, const float* kscale, LAS float* scr, int item, int lane, int pitch = 0) {
    if (pitch == 0) pitch = K;
    const int nblk = N / 32, kb = item / nblk, nb = item % nblk, k0 = 64 * kb, n0 = 32 * nb;
    f32x4 wv[8];
#pragma unroll
    for (int i = 0; i < 8; ++i) wv[i] = *(const f32x4*)(W + (size_t)(k0 + 8 * i + (lane >> 3)) * N + n0 + 4 * (lane & 7));
    if (kscale) {
#pragma unroll
        for (int i = 0; i < 8; ++i) wv[i] = wv[i] * kscale[k0 + 8 * i + (lane >> 3)]; }
#pragma unroll
    for (int i = 0; i < 8; ++i) { LAS float* d = scr + (8 * i + (lane >> 3)) * 33 + 4 * (lane & 7); d[0] = wv[i][0]; d[1] = wv[i][1]; d[2] = wv[i][2]; d[3] = wv[i][3]; }
    asm volatile("s_waitcnt lgkmcnt(0)" ::: "memory");
    const int c = lane & 7;
#pragma unroll
    for (int j = 0; j < 4; ++j) { const int n = (lane >> 3) + 8 * j; const LAS float* s = scr + (8 * c) * 33 + n;
        u32x4 o; o.x = cvtpk(s[0 * 33], s[1 * 33]); o.y = cvtpk(s[2 * 33], s[3 * 33]); o.z = cvtpk(s[4 * 33], s[5 * 33]); o.w = cvtpk(s[6 * 33], s[7 * 33]);
        *(u32x4*)(WT + (size_t)dest_row(mode, n0 + n) * pitch + k0 + 8 * c) = o; }
    asm volatile("s_waitcnt lgkmcnt(0)" ::: "memory");
}
DI void rms_row_to_bf16(const float* xrow, const float* g, bf16_t* orow, int lane) {
    f32x4 v[8]; float s = 0.f;
#pragma unroll
    for (int j = 0; j < 8; ++j) { v[j] = *((const f32x4*)xrow + lane + 64 * j); s += (v[j][0] * v[j][0] + v[j][1] * v[j][1]) + (v[j][2] * v[j][2] + v[j][3] * v[j][3]); }
    const float rstd = rsqrtf(wave_sum(s) * (1.0f / DM) + EPS);
#pragma unroll
    for (int j = 0; j < 8; ++j) { const f32x4 gg = *((const f32x4*)g + lane + 64 * j); u32x2 w; w.x = cvtpk(v[j][0] * rstd * gg[0], v[j][1] * rstd * gg[1]); w.y = cvtpk(v[j][2] * rstd * gg[2], v[j][3] * rstd * gg[3]);
        *((u32x2*)orow + lane + 64 * j) = w; }
}
DI void rms_row_to_bf16_g(const float* xrow, const f32x4 (&gg)[8], bf16_t* orow, int lane) {
    f32x4 v[8]; float s = 0.f;
#pragma unroll
    for (int j = 0; j < 8; ++j) { v[j] = *((const f32x4*)xrow + lane + 64 * j); s += (v[j][0] * v[j][0] + v[j][1] * v[j][1]) + (v[j][2] * v[j][2] + v[j][3] * v[j][3]); }
    const float rstd = rsqrtf(wave_sum(s) * (1.0f / DM) + EPS);
#pragma unroll
    for (int j = 0; j < 8; ++j) { u32x2 w; w.x = cvtpk(v[j][0] * rstd * gg[j][0], v[j][1] * rstd * gg[j][1]); w.y = cvtpk(v[j][2] * rstd * gg[j][2], v[j][3] * rstd * gg[j][3]);
        *((u32x2*)orow + lane + 64 * j) = w; }
}
DI int dorig(int p) { return 64 * ((p >> 2) & 1) + 4 * (p >> 3) + (p & 3); }

DI void p0_prologue(const Ctx& C, LAS unsigned char* lds, int wave, bool first) {
    const int lane = lane_id(), tid = wave * 64 + lane;
    LAS float* scr = (LAS float*)(lds + wave * 16384);
    const int gw = blockIdx.x * 8 + wave, NGW = gridDim.x * 8;
    const int gt = blockIdx.x * 512 + tid, NGT = gridDim.x * 512;
    constexpr int I_IN = 32 * 400, I_BR = 16 * 64, I_O = 32 * 64, I_MEM = 32 * 64, I_UP = 32 * 352, I_DN = 88 * 64;
    constexpr int NITEMS = I_IN + 3 * I_BR + I_O + I_MEM + I_UP + I_DN;
    bf16_t* ws16 = (bf16_t*)C.ws;
    for (int it = gw; it < NITEMS; it += NGW) {
        int r = it;
        if (r < I_IN) { p0_transpose_item(C.w_in, DM, NIN, (bf16_t*)(C.ws + WS_WIN), 1, nullptr, scr, r, lane); continue; } r -= I_IN;
        if (r < 3 * I_BR) { const int z = r / I_BR; p0_transpose_item(C.w_br + (size_t)z * 1024 * DM, 1024, DM, (bf16_t*)(C.ws + WS_WBR) + (size_t)z * DM * 1024, 0, nullptr, scr, r % I_BR, lane); continue; } r -= 3 * I_BR;
        if (r < I_O) { p0_transpose_item(C.w_o, DM, DM, (bf16_t*)(C.ws + WS_WO), 0, nullptr, scr, r, lane); continue; } r -= I_O;
        if (r < I_MEM) { p0_transpose_item(C.w_mem, DM, DM, (bf16_t*)(C.ws + WS_WMEM), 0, nullptr, scr, r, lane); continue; } r -= I_MEM;
        if (r < I_UP) { p0_transpose_item(C.w_up, DM, FF2, (bf16_t*)(C.ws + WS_WUP), 2, C.g_ffn, scr, r, lane); continue; } r -= I_UP;
        p0_transpose_item(C.w_down, FF, DM, (bf16_t*)(C.ws + WS_WDN), 0, nullptr, scr, r, lane, FFP);
    }
    (void)ws16;
    bf16_t* U = (bf16_t*)C.out;
    {
        f32x4 gmix[8];
#pragma unroll
        for (int j = 0; j < 8; ++j) gmix[j] = *((const f32x4*)C.g_mix + lane + 64 * j);
        for (int m = gw; m < MT; m += NGW) rms_row_to_bf16_g(m < MP ? C.xp + (size_t)m * DM : C.xs + (size_t)(m - MP) * DM, gmix, U + (size_t)m * DM, lane);
        for (int m = gw; m < 1024; m += NGW) rms_row_to_bf16(C.memp + (size_t)m * DM, C.g_mem, (bf16_t*)(C.ws + WS_MEMN) + (size_t)m * DM, lane);
    }
    for (int i = gt; i < 2 * 8 * 256 * 128; i += NGT) { const int which = i >= 8 * 256 * 128, e = (i - which * 8 * 256 * 128) * 8;
        const float* src = (which ? C.cmemv : C.cmemk) + e; bf16_t* dst = (bf16_t*)(C.ws + (which ? WS_MV : WS_MK)) + (size_t)1024 * 1024 + e;
        store8bf(dst, *(const f32x4*)src, *(const f32x4*)(src + 4)); }
    for (int i = gt; i < 2 * 8 * 64 * 64; i += NGT) { const int which = i >= 8 * 64 * 64, j = i - which * 8 * 64 * 64, b = j >> 12, rem = j & 4095;
        const float* src = (which ? C.cswav : C.cswak) + ((size_t)b * 128 + 64) * 256 + rem * 4; float* dst = C.out + (which ? O_SWAV_S : O_SWAK_S) + (size_t)b * 128 * 256 + rem * 4;
        *(f32x4*)dst = *(const f32x4*)src; }
    for (int i = gt; i < 64 * 128 * 128; i += NGT) { const int bh = i >> 14, e = (i >> 7) & 127, p = i & 127;
        ((bf16_t*)(C.ws + WS_S0T))[i] = (bf16_t)(cvtpk(C.sret[((size_t)bh * 128 + dorig(p)) * 128 + e], 0.f) & 0xffffu); }
    float* ss = (float*)(C.ws + WS_CTL);
    for (int i = gt; i < 2 * MT; i += NGT) ss[i] = 0.f;
    if (gt == 0) { if (first) *(unsigned*)(C.ws + WS_BAR) = 0u; *(unsigned*)(C.ws + WS_BAR + 256) = 0u; *(unsigned*)(C.ws + WS_BAR + 512) = 0u; }
}

#define MFMA32(a, b, c) __builtin_amdgcn_mfma_f32_32x32x16_bf16((a), (b), (c), 0, 0, 0)
typedef short v4i16_t __attribute__((ext_vector_type(4)));
DI s16x4 tr_read(const LAS unsigned char* p) { return __builtin_bit_cast(s16x4, __builtin_amdgcn_ds_read_tr16_b64_v4i16((LAS v4i16_t*)p)); }
DI bf16x8 tr_pair(const LAS unsigned char* tile, int stride, int rlo, int rhi, int col0, int lane) {
    const int q4 = (lane & 15) >> 2, p = lane & 3, blk = (lane >> 4) & 1;
    const s16x4 lo = tr_read(tile + (rlo + q4) * stride + (col0 + 16 * blk + 4 * p) * 2);
    const s16x4 hi = tr_read(tile + (rhi + q4) * stride + (col0 + 16 * blk + 4 * p) * 2);
    return __builtin_shufflevector(lo, hi, 0, 1, 2, 3, 4, 5, 6, 7);
}
DI bf16x8 pack_step(const f32x16& x, int s) {
    u32x4 p; p.x = cvtpk(x[8 * s], x[8 * s + 1]); p.y = cvtpk(x[8 * s + 2], x[8 * s + 3]); p.z = cvtpk(x[8 * s + 4], x[8 * s + 5]); p.w = cvtpk(x[8 * s + 6], x[8 * s + 7]);
    return __builtin_bit_cast(bf16x8, p);
}
DI void store_pair16(bf16_t* rowp, u32x2 a, u32x2 b, int g, int hh) {
    auto r0 = __builtin_amdgcn_permlane32_swap(a.x, b.x, false, false); a.x = r0[0]; b.x = r0[1];
    auto r1 = __builtin_amdgcn_permlane32_swap(a.y, b.y, false, false); a.y = r1[0]; b.y = r1[1];
    *(u32x4*)(rowp + 8 * g + 8 * hh) = (u32x4){a.x, a.y, b.x, b.y};
}
DI void store_block32(bf16_t* rowp, const f32x16& o, float sc, int hh) {
#pragma unroll
    for (int g = 0; g < 4; g += 2) {
        u32x2 a, b;
        a.x = cvtpk(o[4 * g] * sc, o[4 * g + 1] * sc); a.y = cvtpk(o[4 * g + 2] * sc, o[4 * g + 3] * sc);
        b.x = cvtpk(o[4 * g + 4] * sc, o[4 * g + 5] * sc); b.y = cvtpk(o[4 * g + 6] * sc, o[4 * g + 7] * sc);
        store_pair16(rowp, a, b, g, hh);
    }
}
DI int crow(int i, int h) { return (i & 3) + 8 * (i >> 2) + 4 * h; }
DI f32x16 zero16() { f32x16 z; for (int i = 0; i < 16; ++i) z[i] = 0.f; return z; }
DI size_t seq_rowbase(int sq) { return sq < 4 ? (size_t)sq * 8192 : (size_t)MP + (size_t)(sq - 4) * 64; }

DI void swa_unit(const Ctx& C, LAS unsigned char* lds, int sq, int hk, int c, int w) {
    const int lane = lane_id(), tid = w * 64 + lane, r = lane & 31, hh = lane >> 5;
    constexpr int KSTR = 144;
    LAS unsigned char* Kt = lds; LAS unsigned char* Vt = lds + 192 * KSTR;
    const bool samp = sq >= 4;
    const size_t rowbase = seq_rowbase(sq) + (size_t)c * 64;
    const bf16_t* KS = (const bf16_t*)(C.ws + WS_KS); const bf16_t* VS = (const bf16_t*)(C.ws + WS_VS); bf16_t* QS = (bf16_t*)(C.ws + WS_QS);
    for (int i = tid; i < 192 * 8; i += 512) {
        const int row = i >> 3, ch = i & 7, j = row >> 6, rr = row & 63;
        u32x4 kv = (u32x4){0u, 0u, 0u, 0u}, vv = kv;
        if (samp && j < 2) {
            const size_t o = (((size_t)(sq - 4) * 128 + row) * 4 + hk) * 64 + ch * 8;
            const f32x4 k0 = *(const f32x4*)(C.cswak + o), k1 = *(const f32x4*)(C.cswak + o + 4), v0 = *(const f32x4*)(C.cswav + o), v1 = *(const f32x4*)(C.cswav + o + 4);
            kv.x = cvtpk(k0[0], k0[1]); kv.y = cvtpk(k0[2], k0[3]); kv.z = cvtpk(k1[0], k1[1]); kv.w = cvtpk(k1[2], k1[3]);
            vv.x = cvtpk(v0[0], v0[1]); vv.y = cvtpk(v0[2], v0[3]); vv.z = cvtpk(v1[0], v1[1]); vv.w = cvtpk(v1[2], v1[3]);
        } else {
            const int cc = samp ? 0 : c - 2 + j;
            if (cc >= 0) { const size_t gr = seq_rowbase(sq) + (size_t)cc * 64 + rr; kv = *(const u32x4*)(KS + gr * 256 + hk * 64 + ch * 8); vv = *(const u32x4*)(VS + gr * 256 + hk * 64 + ch * 8); }
        }
        *(LAS u32x4*)(Kt + row * KSTR + ch * 16) = kv; *(LAS u32x4*)(Vt + row * KSTR + ch * 16) = vv;
    }
    const int g = w >> 1, half = w & 1, head = hk * 4 + g;
    bf16_t* qp = QS + (rowbase + 32 * half + r) * 1024 + head * 64;
    bf16x8 qf[4];
#pragma unroll
    for (int s = 0; s < 4; ++s) qf[s] = *(const bf16x8*)(qp + 16 * s + 8 * hh);
    __syncthreads();
    const int kb0 = samp ? 0 : (c >= 2 ? 0 : (2 - c) * 2);
    f32x16 acc[6];
#pragma unroll
    for (int kb = 0; kb < 6; ++kb) { acc[kb] = zero16();
        if (kb >= kb0) {
#pragma unroll
            for (int s = 0; s < 4; ++s) { const bf16x8 a = *(const LAS bf16x8*)(Kt + (32 * kb + r) * KSTR + (16 * s + 8 * hh) * 2); acc[kb] = MFMA32(a, qf[s], acc[kb]); } } }
    const float sk = C.sink[head] * LOG2E;
    float mx = sk;
#pragma unroll
    for (int kb = 0; kb < 6; ++kb) if (kb >= kb0) {
#pragma unroll
        for (int i = 0; i < 16; ++i) mx = fmaxf(mx, acc[kb][i]); }
    mx = fmaxf(mx, __shfl_xor(mx, 32));
    float l = 0.f;
#pragma unroll
    for (int kb = 0; kb < 6; ++kb) if (kb >= kb0) {
#pragma unroll
        for (int i = 0; i < 16; ++i) { const float p = fexp2(acc[kb][i] - mx); acc[kb][i] = p; l += p; } }
    l += __shfl_xor(l, 32); l += fexp2(sk - mx);
    f32x16 o[2]; o[0] = zero16(); o[1] = zero16();
#pragma unroll
    for (int kb = 0; kb < 6; ++kb) if (kb >= kb0) {
#pragma unroll
        for (int s = 0; s < 2; ++s) { const bf16x8 pb = pack_step(acc[kb], s); const int r0 = 32 * kb + 16 * s + 4 * hh;
#pragma unroll
            for (int db = 0; db < 2; ++db) { const bf16x8 a = tr_pair(Vt, KSTR, r0, r0 + 8, 32 * db, lane); o[db] = MFMA32(a, pb, o[db]); } } }
    const float inv = 1.0f / l;
#pragma unroll
    for (int db = 0; db < 2; ++db) store_block32(qp + 32 * db, o[db], inv, hh);
    __syncthreads();
}

DI void mem_unit(const Ctx& C, LAS unsigned char* lds, int sq, int h, int qt, int w) {
    const int lane = lane_id(), tid = w * 64 + lane, r = lane & 31, hh = lane >> 5;
    constexpr int MSTR = 272;
    const bool samp = sq >= 4;
    const size_t qrow = samp ? seq_rowbase(sq) + 32 * (w & 1) + r : seq_rowbase(sq) + (size_t)qt * 256 + 32 * w + r;
    const bool do_store = !samp || w < 2;
    bf16_t* qp = (bf16_t*)(C.ws + WS_QM) + qrow * 1024 + h * 256;
    const bf16_t* Kg = (const bf16_t*)(C.ws + WS_MK) + (size_t)sq * 256 * 1024 + h * 256; const bf16_t* Vg = (const bf16_t*)(C.ws + WS_MV) + (size_t)sq * 256 * 1024 + h * 256;
    f32x16 acc[8];
#pragma unroll
    for (int mb = 0; mb < 8; ++mb) acc[mb] = zero16();
#pragma unroll 1
    for (int dh = 0; dh < 2; ++dh) {
        __syncthreads();
        for (int i = tid; i < 256 * 16; i += 512) { const int row = i >> 4, ch = i & 15; *(LAS u32x4*)(lds + row * MSTR + ch * 16) = *(const u32x4*)(Kg + (size_t)row * 1024 + dh * 128 + ch * 8); }
        bf16x8 qf[8];
#pragma unroll
        for (int s = 0; s < 8; ++s) qf[s] = *(const bf16x8*)(qp + dh * 128 + 16 * s + 8 * hh);
        __syncthreads();
#pragma unroll
        for (int mb = 0; mb < 8; ++mb)
#pragma unroll
            for (int s = 0; s < 8; ++s) { const bf16x8 a = *(const LAS bf16x8*)(lds + (32 * mb + r) * MSTR + (16 * s + 8 * hh) * 2); acc[mb] = MFMA32(a, qf[s], acc[mb]); }
    }
    float mx = -3.0e38f;
#pragma unroll
    for (int mb = 0; mb < 8; ++mb)
#pragma unroll
        for (int i = 0; i < 16; ++i) mx = fmaxf(mx, acc[mb][i]);
    mx = fmaxf(mx, __shfl_xor(mx, 32));
    float l = 0.f; bf16x8 pb[16];
#pragma unroll
    for (int mb = 0; mb < 8; ++mb) {
#pragma unroll
        for (int i = 0; i < 16; ++i) { const float p = fexp2(acc[mb][i] - mx); acc[mb][i] = p; l += p; }
        pb[2 * mb] = pack_step(acc[mb], 0); pb[2 * mb + 1] = pack_step(acc[mb], 1); }
    l += __shfl_xor(l, 32);
    const float inv = 1.0f / l;
#pragma unroll 1
    for (int dh = 0; dh < 2; ++dh) {
        __syncthreads();
        for (int i = tid; i < 256 * 16; i += 512) { const int row = i >> 4, ch = i & 15; *(LAS u32x4*)(lds + row * MSTR + ch * 16) = *(const u32x4*)(Vg + (size_t)row * 1024 + dh * 128 + ch * 8); }
        __syncthreads();
        f32x16 o[4];
#pragma unroll
        for (int db = 0; db < 4; ++db) o[db] = zero16();
#pragma unroll
        for (int ks = 0; ks < 16; ++ks) { const int r0 = 32 * (ks >> 1) + 16 * (ks & 1) + 4 * hh;
#pragma unroll
            for (int db = 0; db < 4; ++db) { const bf16x8 a = tr_pair(lds, MSTR, r0, r0 + 8, 32 * db, lane); o[db] = MFMA32(a, pb[ks], o[db]); } }
        if (do_store) {
#pragma unroll
            for (int db = 0; db < 4; ++db) store_block32(qp + dh * 128 + 32 * db, o[db], inv, hh); }
    }
    __syncthreads();
}

DI bf16_t* ut_ptr(const Ctx& C, int sq, int h, int c) { const size_t idx = sq < 4 ? ((size_t)(sq * 8 + h) * 128 + c) : (size_t)4096 + (size_t)(sq - 4) * 8 + h; return (bf16_t*)C.out + idx * 16384; }
DI void stage_rows128(LAS unsigned char* dst, const bf16_t* src, int nrows, int tid) {
    for (int i = tid; i < nrows * 16; i += 512) { const int row = i >> 4, ch = i & 15; *(LAS u32x4*)(dst + row * 272 + ch * 16) = *(const u32x4*)(src + (size_t)row * 1024 + ch * 8); }
}
DI void retA_unit(const Ctx& C, LAS unsigned char* lds, int sq, int h, int c, int w) {
    const int lane = lane_id(), tid = w * 64 + lane, r = lane & 31, hh = lane >> 5;
    constexpr int RSTR = 272;
    LAS unsigned char* Kt = lds; LAS unsigned char* Vt = lds + 64 * RSTR;
    const size_t rowbase = seq_rowbase(sq) + (size_t)c * 64;
    stage_rows128(Kt, (const bf16_t*)(C.ws + WS_KR) + rowbase * 1024 + h * 128, 64, tid);
    stage_rows128(Vt, (const bf16_t*)(C.ws + WS_VR) + rowbase * 1024 + h * 128, 64, tid);
    __syncthreads();
    const int eb = w >> 1, db0 = (w & 1) * 2;
    f32x16 acc[2]; acc[0] = zero16(); acc[1] = zero16();
#pragma unroll
    for (int s = 0; s < 4; ++s) { const int r0 = 16 * s + 8 * hh;
        const bf16x8 b = tr_pair(Vt, RSTR, r0, r0 + 4, 32 * eb, lane);
#pragma unroll
        for (int x = 0; x < 2; ++x) { const bf16x8 a = tr_pair(Kt, RSTR, r0, r0 + 4, 32 * (db0 + x), lane); acc[x] = MFMA32(a, b, acc[x]); } }
    bf16_t* U = ut_ptr(C, sq, h, c) + (size_t)(32 * eb + r) * 128;
#pragma unroll
    for (int x = 0; x < 2; ++x) store_block32(U + 32 * (db0 + x), acc[x], 1.0f, hh);
    __syncthreads();
}

DI void ret_scan(const Ctx& C, int wave) {
    const int tid = wave * 64 + lane_id();
    const int gt = blockIdx.x * 512 + tid, NGT = gridDim.x * 512;
    for (int it = gt; it < 32 * 4096 + 64 * 4096; it += NGT) {
        if (it < 32 * 4096) {
            const int bh = it >> 12, e = (it >> 5) & 127, p0 = (it & 31) * 4, h = bh & 7;
            const float g64 = fexp2(64.f * log2gamma(h));
            bf16_t* U = (bf16_t*)C.out + (size_t)bh * 128 * 16384 + e * 128 + p0;
            float s0 = 0.f, s1 = 0.f, s2 = 0.f, s3 = 0.f;
#pragma unroll 1
            for (int c0 = 0; c0 < 128; c0 += 16) {
                u32x2 u[16];
#pragma unroll
                for (int k = 0; k < 16; ++k) u[k] = *(const u32x2*)(U + (size_t)(c0 + k) * 16384);
#pragma unroll
                for (int k = 0; k < 16; ++k) { s0 = g64 * (s0 + bflo(u[k].x)); s1 = g64 * (s1 + bfhi(u[k].x)); s2 = g64 * (s2 + bflo(u[k].y)); s3 = g64 * (s3 + bfhi(u[k].y));
                    u32x2 wv; wv.x = cvtpk(s0, s1); wv.y = cvtpk(s2, s3); *(u32x2*)(U + (size_t)(c0 + k) * 16384) = wv; }
            }
            float* O = C.out + O_RET_P + (size_t)bh * 16384 + e;
            O[(size_t)dorig(p0) * 128] = s0; O[(size_t)dorig(p0 + 1) * 128] = s1; O[(size_t)dorig(p0 + 2) * 128] = s2; O[(size_t)dorig(p0 + 3) * 128] = s3;
        } else {
            const int j = it - 32 * 4096, bh = j >> 12, e = (j >> 5) & 127, p0 = (j & 31) * 4, h = bh & 7;
            const float g64 = fexp2(64.f * log2gamma(h));
            const u32x2 u = *(const u32x2*)((const bf16_t*)C.out + ((size_t)4096 + bh) * 16384 + e * 128 + p0);
            const float uu[4] = {bflo(u.x), bfhi(u.x), bflo(u.y), bfhi(u.y)};
#pragma unroll
            for (int k = 0; k < 4; ++k) { const size_t o = ((size_t)bh * 128 + dorig(p0 + k)) * 128 + e; C.out[O_RET_S + o] = g64 * (C.sret[o] + uu[k]); }
        }
    }
}

struct RetCRegs { u32x4 kvq[6]; u32x4 st[4]; };
DI void retC_decode(int u, int& sq, int& h, int& c) { if (u < 4096) { sq = u >> 10; h = (u >> 7) & 7; c = u & 127; } else { const int x = u - 4096; sq = 4 + (x >> 3); h = x & 7; c = 0; } }
DI void retC_get(const Ctx& C, int u, int tid, RetCRegs& R) {
    int sq, h, c; retC_decode(u, sq, h, c);
    const size_t rowbase = seq_rowbase(sq) + (size_t)c * 64; const bool samp = sq >= 4, has_prev = samp || c > 0;
    const bf16_t* Kg = (const bf16_t*)(C.ws + WS_KR) + rowbase * 1024 + h * 128; const bf16_t* Vg = (const bf16_t*)(C.ws + WS_VR) + rowbase * 1024 + h * 128; const bf16_t* Qg = (const bf16_t*)(C.ws + WS_QR) + rowbase * 1024 + h * 128;
#pragma unroll
    for (int k = 0; k < 2; ++k) { const int i = tid + 512 * k, row = i >> 4, ch = i & 15; const size_t o = (size_t)row * 1024 + ch * 8;
        R.kvq[k] = *(const u32x4*)(Kg + o); R.kvq[2 + k] = *(const u32x4*)(Vg + o); R.kvq[4 + k] = *(const u32x4*)(Qg + o); }
    if (has_prev) { const bf16_t* S = samp ? (const bf16_t*)(C.ws + WS_S0T) + (size_t)((sq - 4) * 8 + h) * 16384 : ut_ptr(C, sq, h, c - 1);
#pragma unroll
        for (int k = 0; k < 4; ++k) { const int i = tid + 512 * k, row = i >> 4, ch = i & 15; R.st[k] = *(const u32x4*)(S + (size_t)row * 128 + ch * 8); } }
    else {
#pragma unroll
        for (int k = 0; k < 4; ++k) R.st[k] = (u32x4){0u, 0u, 0u, 0u}; }
}
DI void retC_put(LAS unsigned char* lds, int tid, const RetCRegs& R) {
    constexpr int RSTR = 272;
#pragma unroll
    for (int k = 0; k < 2; ++k) { const int i = tid + 512 * k, row = i >> 4, ch = i & 15;
        *(LAS u32x4*)(lds + row * RSTR + ch * 16) = R.kvq[k]; *(LAS u32x4*)(lds + (64 + row) * RSTR + ch * 16) = R.kvq[2 + k]; *(LAS u32x4*)(lds + (128 + row) * RSTR + ch * 16) = R.kvq[4 + k]; }
#pragma unroll
    for (int k = 0; k < 4; ++k) { const int i = tid + 512 * k, row = i >> 4, ch = i & 15; *(LAS u32x4*)(lds + (192 + row) * RSTR + ch * 16) = R.st[k]; }
}
DI void retC_unit(const Ctx& C, LAS unsigned char* lds, int sq, int h, int c, int w) {
    const int lane = lane_id(), tid = w * 64 + lane, r = lane & 31, hh = lane >> 5;
    constexpr int RSTR = 272;
    LAS unsigned char* Kt = lds; LAS unsigned char* Vt = lds + 64 * RSTR; LAS unsigned char* Qt = lds + 128 * RSTR; LAS unsigned char* St = lds + 192 * RSTR;
    LAS float* red = (LAS float*)(lds + 320 * RSTR);
    const size_t rowbase = seq_rowbase(sq) + (size_t)c * 64;
    const bool samp = sq >= 4, has_prev = samp || c > 0;
    bf16_t* QR = (bf16_t*)(C.ws + WS_QR);
    const int nh = w & 1, eq = w >> 1;
    bf16x8 qf[8];
#pragma unroll
    for (int s = 0; s < 8; ++s) qf[s] = *(const LAS bf16x8*)(Qt + (32 * nh + r) * RSTR + (16 * s + 8 * hh) * 2);
    f32x16 o = zero16();
#pragma unroll
    for (int mb = 0; mb < 2; ++mb) if (mb <= nh) {
        f32x16 P = zero16();
#pragma unroll
        for (int s = 0; s < 8; ++s) { const bf16x8 a = *(const LAS bf16x8*)(Kt + (32 * mb + r) * RSTR + (16 * s + 8 * hh) * 2); P = MFMA32(a, qf[s], P); }
        if (mb == nh) {
#pragma unroll
            for (int i = 0; i < 16; ++i) if (crow(i, hh) > r) P[i] = 0.f; }
#pragma unroll
        for (int s = 0; s < 2; ++s) { const bf16x8 pb = pack_step(P, s); const int r0 = 32 * mb + 16 * s + 4 * hh; const bf16x8 a = tr_pair(Vt, RSTR, r0, r0 + 8, 32 * eq, lane); o = MFMA32(a, pb, o); }
    }
    if (has_prev) {
#pragma unroll
        for (int s = 0; s < 8; ++s) { const bf16x8 a = *(const LAS bf16x8*)(St + (32 * eq + r) * RSTR + (16 * s + 8 * hh) * 2); o = MFMA32(a, qf[s], o); } }
    float ss = 0.f;
#pragma unroll
    for (int i = 0; i < 16; ++i) ss += o[i] * o[i];
    ss += __shfl_xor(ss, 32);
    if (hh == 0) red[(32 * nh + r) * 4 + eq] = ss;
    __syncthreads();
    const f32x4 rr = *(const LAS f32x4*)(red + (32 * nh + r) * 4);
    const float rstd = rsqrtf(((rr[0] + rr[1]) + (rr[2] + rr[3])) * (1.0f / 128.0f) + EPS);
    const size_t orow = (rowbase + 32 * nh + r) * 1024 + h * 128 + 32 * eq;
    const bf16_t* GR = (const bf16_t*)(C.ws + WS_GR);
    u32x2 gt[4];
#pragma unroll
    for (int g4 = 0; g4 < 4; ++g4) gt[g4] = *(const u32x2*)(GR + orow + 8 * g4 + 4 * hh);
#pragma unroll
    for (int g = 0; g < 4; g += 2) { u32x2 a, b;
        a.x = cvtpk(o[4 * g] * rstd * bflo(gt[g].x), o[4 * g + 1] * rstd * bfhi(gt[g].x)); a.y = cvtpk(o[4 * g + 2] * rstd * bflo(gt[g].y), o[4 * g + 3] * rstd * bfhi(gt[g].y));
        b.x = cvtpk(o[4 * g + 4] * rstd * bflo(gt[g + 1].x), o[4 * g + 5] * rstd * bfhi(gt[g + 1].x)); b.y = cvtpk(o[4 * g + 6] * rstd * bflo(gt[g + 1].y), o[4 * g + 7] * rstd * bfhi(gt[g + 1].y));
        store_pair16(QR + orow, a, b, g, hh); }
    __syncthreads();
}

DI void conv_fixup(const Ctx& C, int wave) {
    const int tid = wave * 64 + lane_id();
    const int gt = blockIdx.x * 512 + tid, NGT = gridDim.x * 512;
    const float* RAW = (const float*)(C.ws + WS_RAW); bf16_t* ACT = (bf16_t*)(C.ws + WS_ACT);
    constexpr int F4 = FF / 4;
    for (int it = gt; it < 512 * F4; it += NGT) {
        const int grp = it / F4, f = (it % F4) * 4;
        if ((grp & 127) == 0) continue;
        const float* cur = RAW + (size_t)grp * 4 * 2 * FF + f; const float* prv = RAW + (size_t)(grp - 1) * 4 * 2 * FF + f;
        f32x4 c0[2], c1[2];
#pragma unroll
        for (int gv = 0; gv < 2; ++gv) {
            const f32x4 w0 = *(const f32x4*)(C.w_conv + gv * FF + f), w1 = *(const f32x4*)(C.w_conv + FF2 + gv * FF + f), w2 = *(const f32x4*)(C.w_conv + 2 * FF2 + gv * FF + f), bb = *(const f32x4*)(C.b_conv + gv * FF + f);
            const f32x4 p62 = *(const f32x4*)(prv + (size_t)(2 * 2 + gv) * FF), p63 = *(const f32x4*)(prv + (size_t)(3 * 2 + gv) * FF), a0 = *(const f32x4*)(cur + (size_t)(0 * 2 + gv) * FF), a1 = *(const f32x4*)(cur + (size_t)(1 * 2 + gv) * FF);
            c0[gv] = bb + w0 * p62 + w1 * p63 + w2 * a0; c1[gv] = bb + w0 * p63 + w1 * a0 + w2 * a1;
        }
        u32x2 o0, o1;
        o0.x = cvtpk(silu_f(c0[0][0]) * c0[1][0], silu_f(c0[0][1]) * c0[1][1]); o0.y = cvtpk(silu_f(c0[0][2]) * c0[1][2], silu_f(c0[0][3]) * c0[1][3]);
        o1.x = cvtpk(silu_f(c1[0][0]) * c1[1][0], silu_f(c1[0][1]) * c1[1][1]); o1.y = cvtpk(silu_f(c1[0][2]) * c1[1][2], silu_f(c1[0][3]) * c1[1][3]);
        *(u32x2*)(ACT + (size_t)(grp * 64) * FFP + f) = o0; *(u32x2*)(ACT + (size_t)(grp * 64 + 1) * FFP + f) = o1;
    }
}

DI void conv_merged_s(const Ctx& C, int wave) {
    const int gw = blockIdx.x * 8 + wave, lane = lane_id();
    if (gw < MS) {
        const f32x4* s = (const f32x4*)C.out + (size_t)gw * (DM / 4); u32x2* d = (u32x2*)((bf16_t*)(C.ws + WS_MERGED) + (size_t)(MP + gw) * DM);
#pragma unroll
        for (int j = 0; j < 8; ++j) { f32x4 v = s[lane + 64 * j];
#pragma unroll
            for (int q = 1; q < 6; ++q) v += s[(size_t)q * (MS * DM / 4) + lane + 64 * j];
            u32x2 w; w.x = cvtpk(v[0], v[1]); w.y = cvtpk(v[2], v[3]); d[lane + 64 * j] = w; }
        asm volatile("s_waitcnt vmcnt(0)" ::: "memory");
        __builtin_amdgcn_fence(__ATOMIC_RELEASE, "agent");
        if (lane == 0) __hip_atomic_fetch_add((unsigned*)(C.ws + WS_BAR + 256), 1u, __ATOMIC_RELAXED, __HIP_MEMORY_SCOPE_AGENT);
    }
}
DI void conv_h_s(const Ctx& C, int wave) {
    const int gw = blockIdx.x * 8 + wave, lane = lane_id();
    if (gw < MS) {
        const f32x4* s = (const f32x4*)C.out + (size_t)gw * (DM / 4); const f32x4* x = (const f32x4*)C.xs + (size_t)gw * (DM / 4);
        f32x4* h = (f32x4*)(C.out + (size_t)(MP + gw) * DM); u32x2* d = (u32x2*)((bf16_t*)(C.ws + WS_H1B) + (size_t)(MP + gw) * DM); float ss = 0.f;
#pragma unroll
        for (int j = 0; j < 8; ++j) { f32x4 v = x[lane + 64 * j];
#pragma unroll
            for (int q = 0; q < 4; ++q) v += s[(size_t)q * (MS * DM / 4) + lane + 64 * j];
            h[lane + 64 * j] = v; u32x2 w; w.x = cvtpk(v[0], v[1]); w.y = cvtpk(v[2], v[3]); d[lane + 64 * j] = w; ss += (v[0] * v[0] + v[1] * v[1]) + (v[2] * v[2] + v[3] * v[3]); }
        ss = wave_sum(ss);
        if (lane == 0) ((float*)(C.ws + WS_CTL))[MP + gw] = ss;
        asm volatile("s_waitcnt vmcnt(0)" ::: "memory");
        __builtin_amdgcn_fence(__ATOMIC_RELEASE, "agent");
        if (lane == 0) __hip_atomic_fetch_add((unsigned*)(C.ws + WS_BAR + 512), 1u, __ATOMIC_RELAXED, __HIP_MEMORY_SCOPE_AGENT);
    }
}
DI void final_norm(const Ctx& C, int wave) {
    const int lane = lane_id();
    const int gw = blockIdx.x * 8 + wave, NGW = gridDim.x * 8;
    f32x4 gfin[8];
#pragma unroll
    for (int j = 0; j < 8; ++j) gfin[j] = *((const f32x4*)C.g_final + lane + 64 * j);
    for (int m = gw; m < MT; m += NGW) {
        f32x4* row = (f32x4*)(C.out + (size_t)m * DM);
        f32x4 v[8]; float s = 0.f;
        if (m < MP) {
            const u32x2* hb = (const u32x2*)((const bf16_t*)(C.ws + WS_H1B) + (size_t)m * DM);
#pragma unroll
            for (int j = 0; j < 8; ++j) { const u32x2 h = hb[lane + 64 * j]; v[j] = (f32x4){bflo(h.x), bfhi(h.x), bflo(h.y), bfhi(h.y)}; }
        } else {
            const f32x4* pd = (const f32x4*)(C.ws + WS_VR) + (size_t)(m - MP) * (DM / 4);
#pragma unroll
            for (int j = 0; j < 8; ++j) { v[j] = row[lane + 64 * j];
#pragma unroll
                for (int q = 0; q < 11; ++q) v[j] += pd[(size_t)q * (MS * DM / 4) + lane + 64 * j]; }
        }
#pragma unroll
        for (int j = 0; j < 8; ++j) s += (v[j][0] * v[j][0] + v[j][1] * v[j][1]) + (v[j][2] * v[j][2] + v[j][3] * v[j][3]);
        const float rstd = rsqrtf(wave_sum(s) * (1.0f / DM) + EPS);
#pragma unroll
        for (int j = 0; j < 8; ++j) row[lane + 64 * j] = v[j] * rstd * gfin[j];
    }
}

#define XB_TMO      128
#define XB_XCNT(j)  (256  + 64 * (j))
#define XB_XSUB(j)  (1280 + 64 * (j))
#define XB_XGEN(j)  (2304 + 64 * (j))
#define XB_TOP      3328
#define XB_TOPGEN   3392
#define XCD_BAR_WORDS 3456
#define XB_SPIN_CAP (1u << 18)
constexpr size_t WS_XBAR = 768 * 1024;
DI unsigned xb_ld(unsigned* p)              { return __hip_atomic_load(p, __ATOMIC_RELAXED, __HIP_MEMORY_SCOPE_AGENT); }
DI unsigned xb_add(unsigned* p, unsigned v) { return __hip_atomic_fetch_add(p, v, __ATOMIC_RELAXED, __HIP_MEMORY_SCOPE_AGENT); }
DI unsigned xb_xcc_id() { return (unsigned)__builtin_amdgcn_s_getreg((3 << 11) | 20) & 0xFu; }
#define XB_SPIN(cond, bar) do { unsigned _sp = 0; while (cond) { __builtin_amdgcn_s_sleep(1); \
    if ((++_sp & 255u) == 0u) { if (xb_ld(&(bar)[XB_TMO])) break; if (_sp > XB_SPIN_CAP) { atomicAdd(&(bar)[XB_TMO], 1u); break; } } } } while (0)
struct XcdBarrier { unsigned* bar; unsigned x; volatile LAS unsigned* st; };
DI void xcd_barrier_complete(unsigned* bar, unsigned x, unsigned& nloc, unsigned& nx) {
    const unsigned G = gridDim.x;
    unsigned sum, cnt, mine, sp = 0u;
    for (;;) {
        sum = 0u; cnt = 0u; mine = 0u;
#pragma unroll
        for (unsigned j = 0; j < 16; ++j) { const unsigned c = xb_ld(&bar[XB_XCNT(j)]); sum += c; cnt += (c > 0u) ? 1u : 0u; mine = (j == x) ? c : mine; }
        if (sum == G) break;
        __builtin_amdgcn_s_sleep(1);
        if ((++sp & 255u) == 0u) { if (xb_ld(&bar[XB_TMO])) break; if (sp > XB_SPIN_CAP) { atomicAdd(&bar[XB_TMO], 1u); break; } }
    }
    nloc = mine > 0u ? mine : 1u; nx = cnt > 0u ? cnt : 1u;
}
DI void xcd_barrier(const XcdBarrier& b, int wave) {
    asm volatile("s_waitcnt vmcnt(0)" ::: "memory");
    __syncthreads();
    if (wave == 0 && lane_id() == 0) {
        unsigned* bar = b.bar;
        __builtin_amdgcn_s_waitcnt(0);
        unsigned nloc = b.st[0], nx = b.st[1];
        if (nloc == 0u) { xcd_barrier_complete(bar, b.x, nloc, nx); b.st[0] = nloc; b.st[1] = nx; }
        const unsigned old = xb_add(&bar[XB_XSUB(b.x)], 1u);
        const unsigned gen = old / nloc;
        if (old + 1u == (gen + 1u) * nloc) {
            __builtin_amdgcn_fence(__ATOMIC_RELEASE, "agent");
            asm volatile("s_waitcnt vmcnt(0)" ::: "memory");
            const unsigned og = xb_add(&bar[XB_TOP], 1u);
            const unsigned tg = og / nx;
            if (og + 1u == (tg + 1u) * nx) xb_add(&bar[XB_TOPGEN], 1u);
            else XB_SPIN(xb_ld(&bar[XB_TOPGEN]) == tg, bar);
            __builtin_amdgcn_fence(__ATOMIC_ACQUIRE, "agent");
            xb_add(&bar[XB_XGEN(b.x)], 1u);
            asm volatile("s_waitcnt vmcnt(0)" ::: "memory");
        } else {
            XB_SPIN(xb_ld(&bar[XB_XGEN(b.x)]) == gen, bar);
            __builtin_amdgcn_fence(__ATOMIC_ACQUIRE, "agent");
            asm volatile("s_waitcnt vmcnt(0)" ::: "memory");
        }
    }
    __syncthreads();
}

constexpr int LDS_BYTES = 147456;
#define MKCTX Ctx C; C.xp = args.in[0]; C.xs = args.in[1]; C.memp = args.in[2]; C.cswak = args.in[3]; C.cswav = args.in[4]; C.sret = args.in[5]; C.sconv = args.in[6]; C.cmemk = args.in[7]; C.cmemv = args.in[8]; C.g_mix = args.in[9]; C.w_in = args.in[10]; C.b_gate = args.in[11]; C.sink = args.in[12]; C.w_br = args.in[13]; C.w_o = args.in[14]; C.g_mem = args.in[15]; C.w_mem = args.in[16]; C.g_ffn = args.in[17]; C.w_up = args.in[18]; C.w_conv = args.in[19]; C.b_conv = args.in[20]; C.w_down = args.in[21]; C.g_final = args.in[22]; C.out = args.out; C.ws = args.ws;
__global__ void __launch_bounds__(512, 2) fwd(Args args) {
    extern __shared__ __attribute__((aligned(16))) unsigned char lds_raw[];
    LAS unsigned char* lds = (LAS unsigned char*)lds_raw;
    cg::grid_group grid = cg::this_grid();
    const int wave = __builtin_amdgcn_readfirstlane(threadIdx.x >> 6);
    XcdBarrier xbar; xbar.bar = (unsigned*)(args.ws + WS_XBAR); xbar.x = xb_xcc_id(); xbar.st = (volatile LAS unsigned*)(lds + 131072 + 64);
    if (wave == 0 && lane_id() == 0) { xbar.st[0] = 0u; xbar.st[1] = 0u; (void)xb_add(&xbar.bar[XB_XCNT(xbar.x)], 1u); }
    __syncthreads();
#ifndef PROBE_PREFIX
#define PROBE_PREFIX 0
#endif
    const int G = gridDim.x, bid = blockIdx.x;
    for (int pass = (PROBE_PREFIX ? 0 : 1); pass < 2; ++pass) {
    const int lo = 0, hi = (pass == 0) ? PROBE_PREFIX : 11;
#ifndef PH_MASK
#define PH_MASK 0x7ff
#endif
#define IN(k) (((PH_MASK >> (k)) & 1) && lo <= (k) && (k) < hi)
#ifndef REP_MASK
#define REP_MASK 0
#endif
#define SEAM(k) do { if (!IN(k)) break; if ((k) == 0) grid.sync(); else xcd_barrier(xbar, wave); } while (0)
#define NREP(k) (1 + ((REP_MASK >> (k)) & 1))
    if (IN(0)) { MKCTX; p0_prologue(C, lds, wave, pass == (PROBE_PREFIX ? 0 : 1)); }
    SEAM(0);
    if (IN(1)) {
        MKCTX;
        SchedP1 S{(const char*)C.out, (const char*)(C.ws + WS_WIN), (const char*)(C.ws + WS_MEMN), (const char*)(C.ws + WS_WMEM), G, bid};
        EpiP1 E{(bf16_t*)(C.ws + WS_QS), (bf16_t*)(C.ws + WS_KS), (bf16_t*)(C.ws + WS_VS), (bf16_t*)(C.ws + WS_QR), (bf16_t*)(C.ws + WS_KR), (bf16_t*)(C.ws + WS_VR), (bf16_t*)(C.ws + WS_GR),
                (bf16_t*)(C.ws + WS_QM), (bf16_t*)(C.ws + WS_GT), (bf16_t*)(C.ws + WS_MK), (bf16_t*)(C.ws + WS_MV), C.b_gate, C.out};
        pg8::gemm_phase(lds, DM, S, E, wave);
    }
    SEAM(1);
    if (IN(2)) {
        MKCTX;
        constexpr int N_MEM = 544, N_SWA = 2080, N_RA = 4160;
        for (int u = bid; u < N_MEM + N_SWA + N_RA; u += G) {
            if (u < N_MEM) { if (u < 512) mem_unit(C, lds, u >> 7, (u >> 5) & 3, u & 31, wave); else { const int v = u - 512; mem_unit(C, lds, 4 + (v >> 2), v & 3, 0, wave); } }
            else if (u < N_MEM + N_SWA) { const int v = u - N_MEM; if (v < 2048) swa_unit(C, lds, v >> 9, (v >> 7) & 3, v & 127, wave); else { const int x = v - 2048; swa_unit(C, lds, 4 + (x >> 2), x & 3, 0, wave); } }
            else { const int v = u - N_MEM - N_SWA; if (v < 4096) retA_unit(C, lds, v >> 10, (v >> 7) & 7, v & 127, wave); else { const int x = v - 4096; retA_unit(C, lds, 4 + (x >> 3), x & 7, 0, wave); } }
        }
    }
    SEAM(2);
    if (IN(3)) { MKCTX; ret_scan(C, wave); }
    SEAM(3);
    if (IN(4)) {
        MKCTX;
        {
            const int tid = wave * 64 + lane_id();
            RetCRegs R;
            if (bid < 4160) retC_get(C, bid, tid, R);
            for (int u = bid; u < 4160; u += G) {
                retC_put(lds, tid, R);
                __syncthreads();
                if (u + G < 4160) retC_get(C, u + G, tid, R);
                int sq, h, c; retC_decode(u, sq, h, c);
                retC_unit(C, lds, sq, h, c, wave);
            }
        }
    }
    SEAM(4);
    if (IN(5)) {
        MKCTX;
        SchedMerge S{(const char*)(C.ws + WS_QS), (const char*)(C.ws + WS_QR), (const char*)(C.ws + WS_QM), (const char*)(C.ws + WS_WBR), G, bid};
        EpiMerge E{(const bf16_t*)(C.ws + WS_GT), (bf16_t*)(C.ws + WS_MERGED), C.out, (bf16_t*)(C.ws + WS_GR) + (size_t)bid * 65536};
        pg8::gemm_phase(lds, 1024, S, E, wave);
    }
    SEAM(5);
    if (IN(6)) {
        MKCTX;
        conv_merged_s(C, wave);
        SchedSplit<4> S{(const char*)(C.ws + WS_MERGED), (const char*)(C.ws + WS_WO), G, bid, DM, (const unsigned*)(C.ws + WS_BAR + 256), (unsigned)MS, DM};
        EpiWo E{C.xp, C.out, (bf16_t*)(C.ws + WS_H1B), (float*)(C.ws + WS_CTL)};
        pg8::gemm_phase(lds, DM, S, E, wave);
    }
    SEAM(6);
    if (IN(7)) {
        MKCTX;
        conv_h_s(C, wave);
        SchedSimple S{(const char*)(C.ws + WS_H1B), (const char*)(C.ws + WS_WUP), 130, 44, G, bid, (size_t)256 * DM * 2, 32, (const unsigned*)(C.ws + WS_BAR + 512), (unsigned)MS};
        EpiUp E{(const float*)(C.ws + WS_CTL), C.w_conv, C.b_conv, C.sconv, (bf16_t*)(C.ws + WS_ACT), (float*)(C.ws + WS_RAW), C.out, lds + 131072 + 1024};
        pg8::gemm_phase(lds, DM, S, E, wave);
    }
    SEAM(7);
    if (IN(8)) { MKCTX; conv_fixup(C, wave); }
    SEAM(8);
    if (IN(9)) {
        MKCTX;
        SchedSplit<11> S{(const char*)(C.ws + WS_ACT), (const char*)(C.ws + WS_WDN), G, bid, FF, nullptr, 0u, FFP};
        EpiDown E{(float*)(C.ws + WS_VR), (bf16_t*)(C.ws + WS_H1B)};
        pg8::gemm_phase(lds, FFP, S, E, wave);
    }
    SEAM(9);
    if (IN(10)) { MKCTX; final_norm(C, wave); }
    if (pass == 0) SEAM(10);
    }
#undef IN
#undef SEAM
}

extern "C" void kernel_launch(void* const* d_in, const int* in_sizes, int n_in, void* d_out, int out_size, void* d_ws, size_t ws_size, hipStream_t stream) {
    static int grid = 0;
    if (grid == 0) {
        if (n_in != 23 || (size_t)out_size != O_END || ws_size < WS_END) { fprintf(stderr, "kernel_launch: unexpected shapes n_in %d out %d ws %zu\n", n_in, out_size, ws_size); grid = -1; return; }
        int dev = 0, cus = 0, per_cu = 0;
        (void)hipGetDevice(&dev);
        (void)hipDeviceGetAttribute(&cus, hipDeviceAttributeMultiprocessorCount, dev);
        (void)hipFuncSetAttribute((const void*)fwd, hipFuncAttributeMaxDynamicSharedMemorySize, LDS_BYTES);
        (void)hipOccupancyMaxActiveBlocksPerMultiprocessor(&per_cu, (const void*)fwd, 512, LDS_BYTES);
        if (per_cu < 1) per_cu = 1;
        grid = cus * per_cu;
        if (grid != 256) { fprintf(stderr, "kernel_launch: this kernel is laid out for 256 workgroups (one per CU); got %d\n", grid); grid = -1; return; }
    }
    if (grid < 0) return;
    (void)hipMemsetAsync((char*)d_ws + WS_XBAR, 0, XCD_BAR_WORDS * 4, stream);
    Args a{};
    for (int i = 0; i < 23; ++i) a.in[i] = (const float*)d_in[i];
    a.out = (float*)d_out; a.ws = (unsigned char*)d_ws; a.ph_lo = 0; a.ph_hi = 11;
    void* args[] = {&a};
    hipError_t e = hipLaunchCooperativeKernel((const void*)fwd, dim3(grid), dim3(512), args, LDS_BYTES, stream);
    if (e != hipSuccess) fprintf(stderr, "cooperative launch failed: %s (grid %d)\n", hipGetErrorString(e), grid);
}
```

```cpp
#include <hip/hip_runtime.h>
#include <hip/hip_cooperative_groups.h>
#include <cstdio>
#include <cstdint>
namespace cg = cooperative_groups;

#define DI __device__ __forceinline__
#define LAS __attribute__((address_space(3)))
typedef unsigned short bf16_t;
typedef short bf16x8 __attribute__((ext_vector_type(8)));
typedef short s16x4 __attribute__((ext_vector_type(4)));
typedef float f32x4 __attribute__((ext_vector_type(4)));
typedef float f32x16 __attribute__((ext_vector_type(16)));
typedef unsigned u32x4 __attribute__((ext_vector_type(4)));
typedef unsigned u32x2 __attribute__((ext_vector_type(2)));
typedef float f32x2_t __attribute__((ext_vector_type(2)));
typedef __bf16 bf16x2_t __attribute__((ext_vector_type(2)));

constexpr int MP = 32768, MS = 512, MT = MP + MS;
constexpr int DM = 2048, NIN = 12800, FF = 5632, FF2 = 11264;
constexpr int FFP = 5696;
constexpr float EPS = 1e-6f;
constexpr float LOG2E = 1.4426950408889634f;

constexpr size_t MiB = 1u << 20;
constexpr size_t WS_BAR = 512 * 1024;
constexpr size_t WS_CTL = 0;
constexpr size_t WS_WIN = 1 * MiB;
constexpr size_t WS_WBR = 51 * MiB;
constexpr size_t WS_WO = 63 * MiB;
constexpr size_t WS_WMEM = 71 * MiB;
constexpr size_t WS_WUP = 79 * MiB;
constexpr size_t WS_WDN = 983 * MiB;
constexpr size_t WS_QS = 145 * MiB, WS_QR = 210 * MiB, WS_QM = 275 * MiB, WS_KR = 340 * MiB, WS_VR = 405 * MiB, WS_GR = 470 * MiB;
constexpr size_t WS_KS = 535 * MiB, WS_VS = WS_KS + (size_t)MT * 256 * 2;
constexpr size_t WS_GT = WS_VS + (size_t)MT * 256 * 2;
constexpr size_t WS_MK = WS_GT + (size_t)MT * 6144 * 2, WS_MV = WS_MK + 6 * MiB;
constexpr size_t WS_MEMN = WS_MV + 6 * MiB;
constexpr size_t WS_S0T = WS_MEMN + 4 * MiB;
constexpr size_t WS_MS32 = WS_S0T + 2 * MiB;
constexpr size_t WS_END = WS_MS32 + 4 * MiB;
constexpr size_t WS_MERGED = WS_KR;
constexpr size_t WS_H1B = WS_QS;
constexpr size_t WS_ACT = WS_GT;
constexpr size_t WS_RAW = WS_QM;
static_assert(WS_END <= 983 * MiB && WS_WDN + (size_t)2048 * 5696 * 2 <= 1024 * MiB, "ws map");
static_assert(WS_RAW + (size_t)128 * 4 * 4 * 2 * FF * 4 <= WS_VR, "raw rows");

constexpr size_t O_Y = 0;
constexpr size_t O_SWAK_P = (size_t)MT * DM, O_SWAV_P = O_SWAK_P + 131072, O_RET_P = O_SWAV_P + 131072, O_CONV_P = O_RET_P + 524288,
                 O_MEMK = O_CONV_P + 90112, O_MEMV = O_MEMK + 1048576, O_SWAK_S = O_MEMV + 1048576, O_SWAV_S = O_SWAK_S + 262144,
                 O_RET_S = O_SWAV_S + 262144, O_CONV_S = O_RET_S + 1048576, O_END = O_CONV_S + 180224;

struct Args {
    const float* in[23]; float* out; unsigned char* ws; int ph_lo, ph_hi;
};

struct Ctx {
    const float *xp, *xs, *memp, *cswak, *cswav, *sret, *sconv, *cmemk, *cmemv, *g_mix, *w_in, *b_gate, *sink, *w_br, *w_o, *g_mem, *w_mem, *g_ffn, *w_up, *w_conv, *b_conv, *w_down, *g_final;
    float* out; unsigned char* ws;
};

DI int lane_id() { int l; asm volatile("v_mbcnt_lo_u32_b32 %0, -1, 0\n\tv_mbcnt_hi_u32_b32 %0, -1, %0" : "=v"(l)); return l; }
DI unsigned cvtpk(float lo, float hi) { f32x2_t v = {lo, hi}; bf16x2_t b = __builtin_convertvector(v, bf16x2_t); return __builtin_bit_cast(unsigned, b); }
DI float bf2f(unsigned short h) { return __uint_as_float((unsigned)h << 16); }
DI float bflo(unsigned w) { return __uint_as_float(w << 16); }
DI float bfhi(unsigned w) { return __uint_as_float(w & 0xffff0000u); }
DI float fexp2(float x) { return __builtin_amdgcn_exp2f(x); }
DI float frcp(float x) { return __builtin_amdgcn_rcpf(x); }
DI float silu_f(float x) { return x * frcp(1.f + fexp2(-x * LOG2E)); }
DI float sigm_f(float x) { return frcp(1.f + fexp2(-x * LOG2E)); }
DI float wave_sum(float v) {
#pragma unroll
    for (int o = 1; o < 64; o <<= 1) v += __shfl_xor(v, o);
    return v;
}
DI float log2gamma(int h) { const float x = fexp2(-5.f - (float)h); return -x * (1.f + x * (0.5f + x * (0.33333334f + x * (0.25f + x * (0.2f + x * 0.16666667f))))) * LOG2E; }

namespace pg8 {
constexpr int BM = 256, BK = 64, HALF = 128, HTB = HALF * BK * 2, STAGE_BYTES = 8 * HTB, NXCD = 8, WGM = 8;
DI int lds_byte(int r, int c) { const int st = (r >> 4) * 2 + (c >> 5), rr = r & 15, cc = c & 31, ob = rr * 64 + cc * 2; return st * 1024 + (ob ^ (((ob >> 9) & 1) << 5)); }
DI void stage_rc(int b, int& R, int& C) { const int st = b / 1024, sb = b % 1024, swz = sb ^ (((sb >> 9) & 1) << 5); R = (st >> 1) * 16 + swz / 64; C = (st & 1) * 32 + (swz % 64) / 2; }
DI int perm32(int rho) { const int n = rho >> 4, i = rho & 15; return 8 * (i >> 2) + 4 * n + (i & 3); }
struct Unit { int pm, pn, z, nt, kp; };
DI void tile_map(int L, int nM, int nN, int& pm, int& pn) {
    const int nwg = nM * nN; int wgid = L;
    { const int q = nwg / NXCD, r = nwg % NXCD, xcd = wgid % NXCD, off = wgid / NXCD; wgid = (xcd < r ? xcd * (q + 1) : r * (q + 1) + (xcd - r) * q) + off; }
    const int nig = WGM * nN, gid = wgid / nig, fm = gid * WGM, gsz = (nM - fm) < WGM ? (nM - fm) : WGM;
    pm = fm + ((wgid % nig) % gsz); pn = (wgid % nig) / gsz;
}
template <class Epi, class Sched>
DI void gemm_phase(LAS unsigned char* lds, const int K, const Sched& S, const Epi& E, const int wid) {
    const int lane = lane_id(), tid = wid * 64 + lane, wr = wid >> 2, wc = wid & 3, fr = lane & 15, fq = lane >> 4;
    unsigned voffA[2], voffB[2];
#pragma unroll
    for (int i = 0; i < 2; ++i) { int R, C; stage_rc(tid * 16 + i * 8192, R, C); const int Rb = (R & ~31) + perm32(R & 31);
        voffA[i] = (unsigned)(R * K + C) * 2u; voffB[i] = (unsigned)(Rb * K + C) * 2u; }
    const size_t kstep = (size_t)(BK * 2);
    const size_t hstep = (size_t)HALF * K * 2;
    const unsigned ldsw = (unsigned)wid * 1024u;
    const int aoff = lds_byte(wr * 64 + fr, fq * 8), boff = lds_byte(wc * 32 + fr, fq * 8);
#define PG8_SA(b, h) (((b) * 2 + (h)) * HTB)
#define PG8_SB(b, h) ((4 + (b) * 2 + (h)) * HTB)
#define PG8_STAGE(bufoff, gbase, voff) do { _Pragma("unroll") for (int _i = 0; _i < 2; ++_i) \
        __builtin_amdgcn_global_load_lds((const unsigned*)((const char*)(gbase) + (voff)[_i]), (LAS unsigned*)(lds + (bufoff) + ldsw + _i * 8192), 16, 0, 0); } while (0)
#define PG8_LDA(dst, b, h) do { _Pragma("unroll") for (int m = 0; m < 4; ++m) _Pragma("unroll") for (int k = 0; k < 2; ++k) dst[m][k] = *(const LAS bf16x8*)(lds + PG8_SA(b, h) + aoff + m * 2048 + k * 1024); } while (0)
#define PG8_LDB(dst, b, h) do { _Pragma("unroll") for (int n = 0; n < 2; ++n) _Pragma("unroll") for (int k = 0; k < 2; ++k) dst[n][k] = *(const LAS bf16x8*)(lds + PG8_SB(b, h) + boff + n * 2048 + k * 1024); } while (0)
#define PG8_MMA(ai, bj, At, Bt) do { __builtin_amdgcn_s_setprio(1); _Pragma("unroll") for (int m = 0; m < 4; ++m) _Pragma("unroll") for (int n = 0; n < 2; ++n) _Pragma("unroll") for (int k = 0; k < 2; ++k) \
        acc[ai][bj][m][n] = __builtin_amdgcn_mfma_f32_16x16x32_bf16(Bt[n][k], At[m][k], acc[ai][bj][m][n], 0, 0, 0); __builtin_amdgcn_s_setprio(0); } while (0)
#define PG8_WAIT_V(n) asm volatile("s_waitcnt vmcnt(" #n ")" ::: "memory")
#define PG8_WAIT_L(n) asm volatile("s_waitcnt lgkmcnt(" #n ")" ::: "memory")
#define PG8_BAR __builtin_amdgcn_s_barrier()
#define PG8_SCHED __builtin_amdgcn_sched_barrier(0)
    Unit cur, nxt; int ui = 0;
    if (!S.next(0, cur)) return;
    f32x4 acc[2][2][4][2];
#pragma unroll
    for (int a = 0; a < 2; ++a)
#pragma unroll
        for (int b = 0; b < 2; ++b)
#pragma unroll
            for (int m = 0; m < 4; ++m)
#pragma unroll
                for (int n = 0; n < 2; ++n) acc[a][b][m][n] = (f32x4){0.f, 0.f, 0.f, 0.f};
    bf16x8 At[4][2], B0[2][2], B1[2][2];
    S.a_ready(cur);
    const char* cA = S.aptr(cur); const char* cB = S.bptr(cur);
    PG8_STAGE(PG8_SB(0, 0), cB, voffB); PG8_STAGE(PG8_SB(0, 1), cB + hstep, voffB); PG8_STAGE(PG8_SA(0, 0), cA, voffA); PG8_STAGE(PG8_SA(0, 1), cA + hstep, voffA);
    if (wr == 1) PG8_BAR;
    PG8_WAIT_V(2); PG8_BAR;
    PG8_STAGE(PG8_SB(1, 0), cB + kstep, voffB); PG8_STAGE(PG8_SA(1, 0), cA + kstep, voffA); PG8_STAGE(PG8_SB(1, 1), cB + hstep + kstep, voffB);
    PG8_WAIT_V(6); PG8_BAR;
    for (;;) {
        const bool has_next = S.next(ui + 1, nxt);
        const int nt = cur.nt;
        const char* nA = has_next ? S.aptr(nxt) : cA; const char* nB = has_next ? S.bptr(nxt) : cB;
        for (int t = 0; t < nt; t += 2) {
            const bool last = (t == nt - 2);
            const char* a1 = cA + (size_t)(t + 1) * kstep;
            const char* a2 = last ? nA : cA + (size_t)(t + 2) * kstep; const char* b2 = last ? nB : cB + (size_t)(t + 2) * kstep;
            const char* a3 = a2 + kstep; const char* b3 = b2 + kstep;
            if (last && has_next) S.a_ready(nxt);
            PG8_LDB(B0, 0, 0); PG8_LDB(B1, 0, 1); PG8_SCHED; PG8_LDA(At, 0, 0); PG8_STAGE(PG8_SA(1, 1), a1 + hstep, voffA);
            PG8_WAIT_V(8); PG8_WAIT_L(0); PG8_BAR; PG8_MMA(0, 0, At, B0); PG8_MMA(0, 1, At, B1); PG8_BAR; PG8_SCHED;
            PG8_LDA(At, 0, 1); PG8_STAGE(PG8_SB(0, 0), b2, voffB); PG8_STAGE(PG8_SB(0, 1), b2 + hstep, voffB); PG8_STAGE(PG8_SA(0, 0), a2, voffA);
            PG8_WAIT_V(8); PG8_WAIT_L(0); PG8_BAR; PG8_MMA(1, 0, At, B0); PG8_MMA(1, 1, At, B1); PG8_BAR; PG8_SCHED;
            PG8_LDB(B0, 1, 0); PG8_LDB(B1, 1, 1); PG8_SCHED; PG8_LDA(At, 1, 0); PG8_STAGE(PG8_SA(0, 1), a2 + hstep, voffA);
            PG8_WAIT_V(8); PG8_WAIT_L(0); PG8_BAR; PG8_MMA(0, 0, At, B0); PG8_MMA(0, 1, At, B1); PG8_BAR; PG8_SCHED;
            PG8_LDA(At, 1, 1); PG8_STAGE(PG8_SB(1, 0), b3, voffB); PG8_STAGE(PG8_SB(1, 1), b3 + hstep, voffB); PG8_STAGE(PG8_SA(1, 0), a3, voffA);
            PG8_WAIT_V(8); PG8_WAIT_L(0); PG8_BAR; PG8_MMA(1, 0, At, B0); PG8_MMA(1, 1, At, B1); PG8_BAR; PG8_SCHED;
        }
        if (wr == 0) PG8_BAR;
        E(acc, cur, wr, wc, fr, fq);
        if (!has_next) break;
#pragma unroll
        for (int a = 0; a < 2; ++a)
#pragma unroll
            for (int b = 0; b < 2; ++b)
#pragma unroll
                for (int m = 0; m < 4; ++m)
#pragma unroll
                    for (int n = 0; n < 2; ++n) acc[a][b][m][n] = (f32x4){0.f, 0.f, 0.f, 0.f};
        cur = nxt; cA = nA; cB = nB; ++ui;
        if (wr == 1) PG8_BAR;
    }
    PG8_WAIT_V(0);
    PG8_BAR;
#undef PG8_SA
#undef PG8_SB
#undef PG8_STAGE
#undef PG8_LDA
#undef PG8_LDB
#undef PG8_MMA
#undef PG8_WAIT_V
#undef PG8_WAIT_L
#undef PG8_BAR
#undef PG8_SCHED
}
}
using pg8::Unit;
typedef f32x4 Acc[2][2][4][2];

DI void store8bf(bf16_t* p, f32x4 a, f32x4 b) { u32x4 w; w.x = cvtpk(a[0], a[1]); w.y = cvtpk(a[2], a[3]); w.z = cvtpk(b[0], b[1]); w.w = cvtpk(b[2], b[3]); *(u32x4*)p = w; }

DI void wait_counter(const unsigned* ctr, unsigned target) {
    while (__hip_atomic_load(ctr, __ATOMIC_RELAXED, __HIP_MEMORY_SCOPE_AGENT) < target) __builtin_amdgcn_s_sleep(2);
    __builtin_amdgcn_fence(__ATOMIC_ACQUIRE, "agent");
}
struct SchedSimple {
    const char *A, *B; int nM, nN, G, c; size_t tstep; int ntk; const unsigned* ctr; unsigned target;
    DI bool next(int i, Unit& u) const { const long L = (long)i * G + c; if (L >= (long)nM * nN) return false; pg8::tile_map((int)L, nM, nN, u.pm, u.pn); u.z = 0; u.nt = ntk; u.kp = -1; return true; }
    DI const char* aptr(const Unit& u) const { return A + (size_t)u.pm * tstep; }
    DI const char* bptr(const Unit& u) const { return B + (size_t)u.pn * tstep; }
    DI void a_ready(const Unit& u) const { if (ctr && u.pm >= 128) wait_counter(ctr, target); }
};
struct SchedP1 {
    const char *A, *B, *A2, *B2; int G, c;
    DI bool next(int i, Unit& u) const { long L = (long)i * G + c; u.nt = 32; u.kp = -1; if (L < 130 * 50) { pg8::tile_map((int)L, 130, 50, u.pm, u.pn); u.z = 0; return true; }
        L -= 130 * 50; if (L < 32) { u.pm = (int)(L >> 3); u.pn = (int)(L & 7); u.z = 1; return true; } return false; }
    DI const char* aptr(const Unit& u) const { return (u.z ? A2 : A) + (size_t)u.pm * (256 * 2048 * 2); }
    DI const char* bptr(const Unit& u) const { return (u.z ? B2 : B) + (size_t)u.pn * (256 * 2048 * 2); }
    DI void a_ready(const Unit&) const {}
};
template <int NP>
struct SchedSplit {
    const char *A, *B; int G, c; int K; const unsigned* ctr; unsigned target; int pitch;
    DI bool next(int i, Unit& u) const {
        const int L = i * G + c; int pm, pn, nt, kp; bool ok = true;
        if (L < 1024) { pg8::tile_map(L, 128, 8, pm, pn); nt = K / 64; kp = -1; }
        else { const int P = L - 1024, tile = P / NP; kp = P % NP; pm = 128 + (tile >> 3); pn = tile & 7; nt = 8; ok = P < 16 * NP; }
        u.pm = pm; u.pn = pn; u.z = 0; u.nt = nt; u.kp = kp; return ok; }
    DI const char* aptr(const Unit& u) const { return A + ((size_t)u.pm * 256 * pitch + (u.kp > 0 ? u.kp * 512 : 0)) * 2; }
    DI const char* bptr(const Unit& u) const { return B + ((size_t)u.pn * 256 * pitch + (u.kp > 0 ? u.kp * 512 : 0)) * 2; }
    DI void a_ready(const Unit& u) const { if (ctr && u.pm >= 128) wait_counter(ctr, target); }
};
struct SchedMerge {
    const char *A0, *A1, *A2, *B; int G, c;
    DI bool next(int i, Unit& u) const {
        int pm, pn, z, nt, kp; bool ok = true;
        if (i < 12) { pg8::tile_map((i / 3) * 256 + c, 128, 8, pm, pn); z = i % 3; nt = 16; kp = -1; }
        else { const int L = (i - 12) * 256 + c, tile = L / 6, rem = L % 6; pm = 128 + (tile >> 3); pn = tile & 7; z = rem >> 1; kp = rem & 1; nt = 8; ok = L < 96; }
        u.pm = pm; u.pn = pn; u.z = z; u.nt = nt; u.kp = kp; return ok; }
    DI const char* aptr(const Unit& u) const { return (u.z == 0 ? A0 : (u.z == 1 ? A1 : A2)) + ((size_t)u.pm * 256 * 1024 + (u.kp > 0 ? 512 : 0)) * 2; }
    DI const char* bptr(const Unit& u) const { return B + (((size_t)u.z * 2048 + (size_t)u.pn * 256) * 1024 + (u.kp > 0 ? 512 : 0)) * 2; }
    DI void a_ready(const Unit&) const {}
};

struct EpiP1 {
    bf16_t *QS, *KS, *VS, *QR, *KR, *VR, *GR, *QM, *GT, *MK, *MV; const float* b_gate; float* out;
    DI void plain(const Acc& acc, bf16_t* O, int ld, int col0, int row0, float sc, int act) const {
#pragma unroll
        for (int ai = 0; ai < 2; ++ai)
#pragma unroll
            for (int m = 0; m < 4; ++m) { bf16_t* rowp = O + (size_t)(row0 + ai * 128 + m * 16) * ld + col0;
#pragma unroll
                for (int bj = 0; bj < 2; ++bj) { f32x4 v0 = acc[ai][bj][m][0] * sc, v1 = acc[ai][bj][m][1] * sc;
                    if (act == 1) {
#pragma unroll
                        for (int j = 0; j < 4; ++j) { v0[j] = silu_f(v0[j]); v1[j] = silu_f(v1[j]); } }
                    store8bf(rowp + bj * 128, v0, v1); } }
    }
    DI void operator()(const Acc& acc, const Unit& u, int wr, int wc, int fr, int fq) const {
        asm volatile("" : "+v"(fr), "+v"(fq));
        const int row0 = u.pm * 256 + wr * 64 + fr, cl = wc * 32 + 8 * fq;
        if (u.z == 1) {
            bf16_t* Ob = (u.pn < 4) ? MK : MV; float* Of = out + ((u.pn < 4) ? O_MEMK : O_MEMV); const int c0 = (u.pn & 3) * 256 + cl;
#pragma unroll
            for (int ai = 0; ai < 2; ++ai)
#pragma unroll
                for (int m = 0; m < 4; ++m) { const size_t r = (size_t)(row0 + ai * 128 + m * 16);
#pragma unroll
                    for (int bj = 0; bj < 2; ++bj) { store8bf(Ob + r * 1024 + c0 + bj * 128, acc[ai][bj][m][0], acc[ai][bj][m][1]);
                        *(f32x4*)(Of + r * 1024 + c0 + bj * 128) = acc[ai][bj][m][0]; *(f32x4*)(Of + r * 1024 + c0 + bj * 128 + 4) = acc[ai][bj][m][1]; } }
            return;
        }
        const int pn = u.pn;
        if (pn < 4) { plain(acc, QS, 1024, pn * 256 + cl, row0, 0.125f * LOG2E, 0); return; }
        if (pn < 6) {
            bf16_t* O = (pn == 4) ? KS : VS; plain(acc, O, 256, cl, row0, 1.f, 0);
            if (u.pm >= 128) {
                float* Of = out + ((pn == 4) ? O_SWAK_S : O_SWAV_S);
#pragma unroll
                for (int ai = 0; ai < 2; ++ai) { const int b = (u.pm - 128) * 4 + 2 * ai + wr;
#pragma unroll
                    for (int m = 0; m < 4; ++m) { float* rp = Of + ((size_t)b * 128 + 64 + 16 * m + fr) * 256 + cl;
#pragma unroll
                        for (int bj = 0; bj < 2; ++bj) { *(f32x4*)(rp + bj * 128) = acc[ai][bj][m][0]; *(f32x4*)(rp + bj * 128 + 4) = acc[ai][bj][m][1]; } } }
            } else if ((u.pm & 31) == 31) {
                float* Of = out + ((pn == 4) ? O_SWAK_P : O_SWAV_P); const int b = u.pm >> 5;
#pragma unroll
                for (int m = 0; m < 4; ++m) { float* rp = Of + ((size_t)b * 128 + 64 * wr + 16 * m + fr) * 256 + cl;
#pragma unroll
                    for (int bj = 0; bj < 2; ++bj) { *(f32x4*)(rp + bj * 128) = acc[1][bj][m][0]; *(f32x4*)(rp + bj * 128 + 4) = acc[1][bj][m][1]; } }
            }
            return;
        }
        if (pn < 14) {
            const bool isq = pn < 10; bf16_t* O = isq ? QR : KR; const int hb = 2 * (pn - (isq ? 6 : 10));
            const int i0 = 16 * wc + 4 * fq; float invf[4];
#pragma unroll
            for (int j = 0; j < 4; ++j) invf[j] = fexp2(-(float)(i0 + j) * (13.287712379549449f / 63.0f));
            const float lg0 = log2gamma(hb), lg1 = log2gamma(hb + 1);
#pragma unroll
            for (int ai = 0; ai < 2; ++ai)
#pragma unroll
                for (int m = 0; m < 4; ++m) {
                    const int row = row0 + ai * 128 + m * 16; const int nl = 16 * m + fr;
                    const float pos = (u.pm >= 128) ? (float)(1024 + nl) : (float)(row & 8191);
                    float cs[4], sn[4];
#pragma unroll
                    for (int j = 0; j < 4; ++j) { float rev = (pos * invf[j]) * 0.15915494309189535f; rev = rev - floorf(rev); cs[j] = __builtin_amdgcn_cosf(rev); sn[j] = __builtin_amdgcn_sinf(rev); }
#pragma unroll
                    for (int bj = 0; bj < 2; ++bj) {
                        const float e = (float)(nl + 1) * (bj ? lg1 : lg0);
                        const float sc = isq ? fexp2(e) : 0.08838834764831845f * fexp2(-e);
                        const f32x4 x1 = acc[ai][bj][m][0], x2 = acc[ai][bj][m][1]; f32x4 o1, o2;
#pragma unroll
                        for (int j = 0; j < 4; ++j) { o1[j] = (x1[j] * cs[j] - x2[j] * sn[j]) * sc; o2[j] = (x1[j] * sn[j] + x2[j] * cs[j]) * sc; }
                        store8bf(O + (size_t)row * 1024 + (hb + bj) * 128 + cl, o1, o2);
                    }
                }
            return;
        }
        if (pn < 18) { plain(acc, VR, 1024, (pn - 14) * 256 + cl, row0, 1.f, 0); return; }
        if (pn < 22) { plain(acc, GR, 1024, (pn - 18) * 256 + cl, row0, 1.f, 1); return; }
        if (pn < 26) { plain(acc, QM, 1024, (pn - 22) * 256 + cl, row0, 0.0625f * LOG2E, 0); return; }
        {
            const int c0 = (pn - 26) * 256 + cl; f32x4 bv[2][2];
#pragma unroll
            for (int bj = 0; bj < 2; ++bj)
#pragma unroll
                for (int n = 0; n < 2; ++n) bv[bj][n] = *(const f32x4*)(b_gate + c0 + bj * 128 + 4 * n);
#pragma unroll
            for (int ai = 0; ai < 2; ++ai)
#pragma unroll
                for (int m = 0; m < 4; ++m) {
                    u32x4 qw;
#pragma unroll
                    for (int bj = 0; bj < 2; ++bj) { f32x4 v0 = acc[ai][bj][m][0] + bv[bj][0], v1 = acc[ai][bj][m][1] + bv[bj][1];
#pragma unroll
                        for (int j = 0; j < 4; ++j) { v0[j] = sigm_f(v0[j]); v1[j] = sigm_f(v1[j]); }
                        const unsigned lo = (unsigned)(v0[0] * 255.f + 0.5f) | ((unsigned)(v0[1] * 255.f + 0.5f) << 8) | ((unsigned)(v0[2] * 255.f + 0.5f) << 16) | ((unsigned)(v0[3] * 255.f + 0.5f) << 24);
                        const unsigned hi = (unsigned)(v1[0] * 255.f + 0.5f) | ((unsigned)(v1[1] * 255.f + 0.5f) << 8) | ((unsigned)(v1[2] * 255.f + 0.5f) << 16) | ((unsigned)(v1[3] * 255.f + 0.5f) << 24);
                        if (bj == 0) { qw.x = lo; qw.y = hi; } else { qw.z = lo; qw.w = hi; } }
                    *(u32x4*)((unsigned char*)GT + ((size_t)u.pm * 24 + (pn - 26)) * 65536 + ((size_t)(((wr * 4 + wc) * 8 + ai * 4 + m) * 64 + fq * 16 + fr)) * 16) = qw; }
        }
    }
};

DI float gq(unsigned w, int j) { return (float)((w >> (8 * j)) & 255u) * (1.0f / 255.0f); }
struct EpiMerge {
    const bf16_t* GT; bf16_t* MG; float* MS32; bf16_t* T;
    DI void operator()(const Acc& acc, const Unit& u, int wr, int wc, int fr, int fq) const {
        asm volatile("" : "+v"(fr), "+v"(fq));
        const int row0 = u.pm * 256 + wr * 64 + fr, c0 = u.pn * 256 + wc * 32 + 8 * fq;
        bf16_t* Tp = T + ((size_t)((wr * 4 + wc) * 16) * 64 + fq * 16 + fr) * 8;
        if (u.kp >= 0) {
            float* P = MS32 + (size_t)(u.z * 2 + u.kp) * MS * DM;
#pragma unroll
            for (int ai = 0; ai < 2; ++ai) {
                u32x2 g[4][2];
#pragma unroll
                for (int m = 0; m < 4; ++m) { const u32x4 gw = *(const u32x4*)((const unsigned char*)GT + ((size_t)u.pm * 24 + u.z * 8 + u.pn) * 65536 + ((size_t)(((wr * 4 + wc) * 8 + ai * 4 + m) * 64 + fq * 16 + fr)) * 16); g[m][0] = (u32x2){gw.x, gw.y}; g[m][1] = (u32x2){gw.z, gw.w}; }
#pragma unroll
                for (int m = 0; m < 4; ++m)
#pragma unroll
                    for (int bj = 0; bj < 2; ++bj) { const u32x2 gg = g[m][bj]; float* d = P + (size_t)(row0 - MP + ai * 128 + m * 16) * 2048 + c0 + bj * 128;
                        f32x4 v0 = acc[ai][bj][m][0], v1 = acc[ai][bj][m][1];
                        v0[0] *= gq(gg.x, 0); v0[1] *= gq(gg.x, 1); v0[2] *= gq(gg.x, 2); v0[3] *= gq(gg.x, 3); v1[0] *= gq(gg.y, 0); v1[1] *= gq(gg.y, 1); v1[2] *= gq(gg.y, 2); v1[3] *= gq(gg.y, 3);
                        *(f32x4*)d = v0; *(f32x4*)(d + 4) = v1; }
                asm volatile("" ::: "memory");
            }
            return;
        }
#pragma unroll
        for (int ai = 0; ai < 2; ++ai) {
            u32x2 g[4][2]; u32x4 p[4][2];
#pragma unroll
            for (int m = 0; m < 4; ++m) { const u32x4 gw = *(const u32x4*)((const unsigned char*)GT + ((size_t)u.pm * 24 + u.z * 8 + u.pn) * 65536 + ((size_t)(((wr * 4 + wc) * 8 + ai * 4 + m) * 64 + fq * 16 + fr)) * 16); g[m][0] = (u32x2){gw.x, gw.y}; g[m][1] = (u32x2){gw.z, gw.w}; }
            if (u.z > 0) {
#pragma unroll
                for (int m = 0; m < 4; ++m)
#pragma unroll
                    for (int bj = 0; bj < 2; ++bj) p[m][bj] = *(const u32x4*)(Tp + (size_t)(ai * 8 + m * 2 + bj) * 512);
            } else {
#pragma unroll
                for (int m = 0; m < 4; ++m)
#pragma unroll
                    for (int bj = 0; bj < 2; ++bj) p[m][bj] = (u32x4){0u, 0u, 0u, 0u};
            }
#pragma unroll
            for (int m = 0; m < 4; ++m)
#pragma unroll
                for (int bj = 0; bj < 2; ++bj) {
                    const u32x2 gg = g[m][bj]; const u32x4 pp = p[m][bj];
                    f32x4 v0 = acc[ai][bj][m][0], v1 = acc[ai][bj][m][1];
                    v0[0] = v0[0] * gq(gg.x, 0) + bflo(pp.x); v0[1] = v0[1] * gq(gg.x, 1) + bfhi(pp.x); v0[2] = v0[2] * gq(gg.x, 2) + bflo(pp.y); v0[3] = v0[3] * gq(gg.x, 3) + bfhi(pp.y);
                    v1[0] = v1[0] * gq(gg.y, 0) + bflo(pp.z); v1[1] = v1[1] * gq(gg.y, 1) + bfhi(pp.z); v1[2] = v1[2] * gq(gg.y, 2) + bflo(pp.w); v1[3] = v1[3] * gq(gg.y, 3) + bfhi(pp.w);
                    if (u.z < 2) store8bf(Tp + (size_t)(ai * 8 + m * 2 + bj) * 512, v0, v1);
                    else store8bf(MG + (size_t)(row0 + ai * 128 + m * 16) * 2048 + c0 + bj * 128, v0, v1);
                }
            asm volatile("" ::: "memory");
        }
    }
};

DI void partial_tile(const Acc& acc, float* P, int rows0, int c0) {
#pragma unroll
    for (int ai = 0; ai < 2; ++ai)
#pragma unroll
        for (int m = 0; m < 4; ++m)
#pragma unroll
            for (int bj = 0; bj < 2; ++bj) { float* d = P + (size_t)(rows0 + ai * 128 + m * 16) * DM + c0 + bj * 128; *(f32x4*)d = acc[ai][bj][m][0]; *(f32x4*)(d + 4) = acc[ai][bj][m][1]; }
}
struct EpiWo {
    const float* xp; float* PART; bf16_t* H1B; float* ss1;
    DI void operator()(const Acc& acc, const Unit& u, int wr, int wc, int fr, int fq) const {
        const int row0 = u.pm * 256 + wr * 64 + fr, c0 = u.pn * 256 + wc * 32 + 8 * fq;
        if (u.kp >= 0) { partial_tile(acc, PART + (size_t)u.kp * MS * DM, row0 - MP, c0); return; }
#pragma unroll
        for (int ai = 0; ai < 2; ++ai) {
            f32x4 xv[4][2][2];
#pragma unroll
            for (int m = 0; m < 4; ++m)
#pragma unroll
                for (int bj = 0; bj < 2; ++bj) { const size_t o = (size_t)(row0 + ai * 128 + m * 16) * DM + c0 + bj * 128; xv[m][bj][0] = *(const f32x4*)(xp + o); xv[m][bj][1] = *(const f32x4*)(xp + o + 4); }
#pragma unroll
            for (int m = 0; m < 4; ++m) { const size_t r = (size_t)(row0 + ai * 128 + m * 16); float s = 0.f;
#pragma unroll
                for (int bj = 0; bj < 2; ++bj) { const size_t o = r * DM + c0 + bj * 128;
                    const f32x4 v0 = acc[ai][bj][m][0] + xv[m][bj][0], v1 = acc[ai][bj][m][1] + xv[m][bj][1];
                    store8bf(H1B + o, v0, v1);
                    s += (v0[0] * v0[0] + v0[1] * v0[1]) + (v0[2] * v0[2] + v0[3] * v0[3]) + (v1[0] * v1[0] + v1[1] * v1[1]) + (v1[2] * v1[2] + v1[3] * v1[3]); }
                s += __shfl_xor(s, 16); s += __shfl_xor(s, 32);
                if (fq == 0) atomicAdd(ss1 + r, s); }
            asm volatile("" ::: "memory");
        }
    }
};

struct EpiDown {
    float* PART; bf16_t* H1B;
    DI void operator()(const Acc& acc, const Unit& u, int wr, int wc, int fr, int fq) const {
        const int row0 = u.pm * 256 + wr * 64 + fr, c0 = u.pn * 256 + wc * 32 + 8 * fq;
        if (u.kp >= 0) { partial_tile(acc, PART + (size_t)u.kp * MS * DM, row0 - MP, c0); return; }
#pragma unroll
        for (int ai = 0; ai < 2; ++ai) {
            u32x4 hv[4][2];
#pragma unroll
            for (int m = 0; m < 4; ++m)
#pragma unroll
                for (int bj = 0; bj < 2; ++bj) hv[m][bj] = *(const u32x4*)(H1B + (size_t)(row0 + ai * 128 + m * 16) * DM + c0 + bj * 128);
#pragma unroll
            for (int m = 0; m < 4; ++m)
#pragma unroll
                for (int bj = 0; bj < 2; ++bj) { const u32x4 h = hv[m][bj]; f32x4 v0 = acc[ai][bj][m][0], v1 = acc[ai][bj][m][1];
                    v0[0] += bflo(h.x); v0[1] += bfhi(h.x); v0[2] += bflo(h.y); v0[3] += bfhi(h.y); v1[0] += bflo(h.z); v1[1] += bfhi(h.z); v1[2] += bflo(h.w); v1[3] += bfhi(h.w);
                    store8bf(H1B + (size_t)(row0 + ai * 128 + m * 16) * DM + c0 + bj * 128, v0, v1); }
            asm volatile("" ::: "memory");
        }
    }
};

template <int CTRL> DI float dpp_ror(float v) { return __builtin_bit_cast(float, __builtin_amdgcn_update_dpp(0, __builtin_bit_cast(int, v), CTRL, 0xf, 0xf, false)); }

struct EpiUp {
    const float *ss1, *w_conv, *b_conv, *sconv; bf16_t* ACT; float* RAW; float* out; LAS unsigned char* xl;
    template <int GV>
    DI void conv_cols(const Acc& acc, const Unit& u, int ai, int n, int G, int f, int fr, const float (&rs)[4], bool samp, int sb, const f32x4 (&cw)[4], f32x4 (&cg)[4], bf16_t* actp) const {
        f32x4 X[4];
#pragma unroll
        for (int m = 0; m < 4; ++m) X[m] = acc[ai][GV][m][n] * rs[m];
        f32x4 Hh = (f32x4){0.f, 0.f, 0.f, 0.f};
        if (samp) { if (fr >= 14) Hh = *(const f32x4*)(sconv + ((size_t)sb * 2 + (fr - 14)) * FF2 + GV * FF + f); }
        else {
            float* rw = RAW + ((((size_t)u.pm * 4 + G) * 4) * 2 + GV) * FF + f;
            if (fr < 2 || fr >= 14) *(f32x4*)(rw + (size_t)(fr < 2 ? fr : fr - 12) * 2 * FF) = (fr < 2) ? X[0] : X[3];
        }
        if (fr >= 14) {
            if (samp) *(f32x4*)(out + O_CONV_S + ((size_t)sb * 2 + (fr - 14)) * FF2 + GV * FF + f) = X[3];
            else if ((u.pm & 31) == 31 && G == 3) *(f32x4*)(out + O_CONV_P + ((size_t)(u.pm >> 5) * 2 + (fr - 14)) * FF2 + GV * FF + f) = X[3];
        }
#pragma unroll
        for (int m = 0; m < 4; ++m) {
            f32x4 p1, p2;
#pragma unroll
            for (int j = 0; j < 4; ++j) {
                const float prev = (m == 0) ? Hh[j] : X[m - 1][j];
                const float a1 = dpp_ror<0x121>(X[m][j]), b1 = dpp_ror<0x121>(prev);
                const float a2 = dpp_ror<0x122>(X[m][j]), b2 = dpp_ror<0x122>(prev);
                p1[j] = (fr >= 1) ? a1 : b1; p2[j] = (fr >= 2) ? a2 : b2;
            }
            const f32x4 c = cw[3] + cw[0] * p2 + cw[1] * p1 + cw[2] * X[m];
            if (GV == 0) cg[m] = c;
            else { u32x2 wv; wv.x = cvtpk(silu_f(cg[m][0]) * c[0], silu_f(cg[m][1]) * c[1]); wv.y = cvtpk(silu_f(cg[m][2]) * c[2], silu_f(cg[m][3]) * c[3]);
                *(u32x2*)(actp + (size_t)(m * 16) * FFP) = wv; }
        }
    }
    DI void operator()(const Acc& acc, const Unit& u, int wr, int wc, int fr, int fq) const {
        asm volatile("" : "+v"(fr), "+v"(fq));
        const int row0 = u.pm * 256 + wr * 64 + fr; const int f0 = u.pn * 128 + wc * 32 + 8 * fq; const bool samp = u.pm >= 128;
        {
            const int t = (wr * 4 + wc) * 64 + fq * 16 + fr;
            LAS float* cwl = (LAS float*)xl; LAS float* ssl = cwl + 1024;
            if (t < 256) { const int q = t >> 5, f4 = (t & 31) * 4, gv = q >> 2, tap = q & 3;
                *(LAS f32x4*)(cwl + q * 128 + f4) = *(const f32x4*)((tap < 3 ? w_conv + (size_t)tap * FF2 : b_conv) + gv * FF + u.pn * 128 + f4); }
            else if (t < 320) *(LAS f32x4*)(ssl + (t - 256) * 4) = *(const f32x4*)(ss1 + (size_t)u.pm * 256 + (t - 256) * 4);
            asm volatile("s_waitcnt lgkmcnt(0)" ::: "memory");
            __builtin_amdgcn_s_barrier();
            asm volatile("" ::: "memory");
        }
        const LAS float* cwl = (const LAS float*)xl; const LAS float* ssl = cwl + 1024;
        float rs[2][4];
#pragma unroll
        for (int ai = 0; ai < 2; ++ai)
#pragma unroll
            for (int m = 0; m < 4; ++m) rs[ai][m] = rsqrtf(ssl[wr * 64 + fr + ai * 128 + m * 16] * (1.0f / DM) + EPS);
#pragma unroll
        for (int n = 0; n < 2; ++n) {
            const int f = f0 + 4 * n; const int fl = wc * 32 + 8 * fq + 4 * n;
            f32x4 cwg[4], cwv[4];
#pragma unroll
            for (int t = 0; t < 4; ++t) { cwg[t] = *(const LAS f32x4*)(cwl + t * 128 + fl); cwv[t] = *(const LAS f32x4*)(cwl + (4 + t) * 128 + fl); }
#pragma unroll
            for (int ai = 0; ai < 2; ++ai) {
                const int G = 2 * ai + wr; const int sb = (u.pm - 128) * 4 + G;
                f32x4 cg[4];
                conv_cols<0>(acc, u, ai, n, G, f, fr, rs[ai], samp, sb, cwg, cg, nullptr);
                conv_cols<1>(acc, u, ai, n, G, f, fr, rs[ai], samp, sb, cwv, cg, ACT + (size_t)(row0 + ai * 128) * FFP + f);
            }
            asm volatile("" ::: "memory");
        }
    }
};

DI int dest_row(int mode, int n) {
    if (mode == 1) { if (n >= 1536 && n < 3584) { const int hd = (n - 1536) >> 7, d = (n - 1536) & 127, half = d >> 6, i = d & 63; return 1536 + hd * 128 + 8 * (i >> 2) + 4 * half + (i & 3); } return n; }
    if (mode == 2) { const int gv = n >= FF ? 1 : 0, f = n - gv * FF; return 256 * (f >> 7) + 128 * gv + (f & 127); }
    return n;
}
DI void p0_transpose_item(const float* W, int K, int N, bf16_t* WT, int mode, const float* kscale, LAS float* scr, int item, int lane, int pitch = 0) {
    if (pitch == 0) pitch = K;
    const int nblk = N / 32, kb = item / nblk, nb = item % nblk, k0 = 64 * kb, n0 = 32 * nb;
    f32x4 wv[8];
#pragma unroll
    for (int i = 0; i < 8; ++i) wv[i] = *(const f32x4*)(W + (size_t)(k0 + 8 * i + (lane >> 3)) * N + n0 + 4 * (lane & 7));
    if (kscale) {
#pragma unroll
        for (int i = 0; i < 8; ++i) wv[i] = wv[i] * kscale[k0 + 8 * i + (lane >> 3)]; }
#pragma unroll
    for (int i = 0; i < 8; ++i) { LAS float* d = scr + (8 * i + (lane >> 3)) * 33 + 4 * (lane & 7); d[0] = wv[i][0]; d[1] = wv[i][1]; d[2] = wv[i][2]; d[3] = wv[i][3]; }
    asm volatile("s_waitcnt lgkmcnt(0)" ::: "memory");
    const int c = lane & 7;
#pragma unroll
    for (int j = 0; j < 4; ++j) { const int n = (lane >> 3) + 8 * j; const LAS float* s = scr + (8 * c) * 33 + n;
        u32x4 o; o.x = cvtpk(s[0 * 33], s[1 * 33]); o.y = cvtpk(s[2 * 33], s[3 * 33]); o.z = cvtpk(s[4 * 33], s[5 * 33]); o.w = cvtpk(s[6 * 33], s[7 * 33]);
        *(u32x4*)(WT + (size_t)dest_row(mode, n0 + n) * pitch + k0 + 8 * c) = o; }
    asm volatile("s_waitcnt lgkmcnt(0)" ::: "memory");
}
DI void rms_row_to_bf16(const float* xrow, const float* g, bf16_t* orow, int lane) {
    f32x4 v[8]; float s = 0.f;
#pragma unroll
    for (int j = 0; j < 8; ++j) { v[j] = *((const f32x4*)xrow + lane + 64 * j); s += (v[j][0] * v[j][0] + v[j][1] * v[j][1]) + (v[j][2] * v[j][2] + v[j][3] * v[j][3]); }
    const float rstd = rsqrtf(wave_sum(s) * (1.0f / DM) + EPS);
#pragma unroll
    for (int j = 0; j < 8; ++j) { const f32x4 gg = *((const f32x4*)g + lane + 64 * j); u32x2 w; w.x = cvtpk(v[j][0] * rstd * gg[0], v[j][1] * rstd * gg[1]); w.y = cvtpk(v[j][2] * rstd * gg[2], v[j][3] * rstd * gg[3]);
        *((u32x2*)orow + lane + 64 * j) = w; }
}
DI void rms_row_to_bf16_g(const float* xrow, const f32x4 (&gg)[8], bf16_t* orow, int lane) {
    f32x4 v[8]; float s = 0.f;
#pragma unroll
    for (int j = 0; j < 8; ++j) { v[j] = *((const f32x4*)xrow + lane + 64 * j); s += (v[j][0] * v[j][0] + v[j][1] * v[j][1]) + (v[j][2] * v[j][2] + v[j][3] * v[j][3]); }
    const float rstd = rsqrtf(wave_sum(s) * (1.0f / DM) + EPS);
#pragma unroll
    for (int j = 0; j < 8; ++j) { u32x2 w; w.x = cvtpk(v[j][0] * rstd * gg[j][0], v[j][1] * rstd * gg[j][1]); w.y = cvtpk(v[j][2] * rstd * gg[j][2], v[j][3] * rstd * gg[j][3]);
        *((u32x2*)orow + lane + 64 * j) = w; }
}
DI int dorig(int p) { return 64 * ((p >> 2) & 1) + 4 * (p >> 3) + (p & 3); }

DI void p0_prologue(const Ctx& C, LAS unsigned char* lds, int wave, bool first) {
    const int lane = lane_id(), tid = wave * 64 + lane;
    LAS float* scr = (LAS float*)(lds + wave * 16384);
    const int gw = blockIdx.x * 8 + wave, NGW = gridDim.x * 8;
    const int gt = blockIdx.x * 512 + tid, NGT = gridDim.x * 512;
    constexpr int I_IN = 32 * 400, I_BR = 16 * 64, I_O = 32 * 64, I_MEM = 32 * 64, I_UP = 32 * 352, I_DN = 88 * 64;
    constexpr int NITEMS = I_IN + 3 * I_BR + I_O + I_MEM + I_UP + I_DN;
    bf16_t* ws16 = (bf16_t*)C.ws;
    for (int it = gw; it < NITEMS; it += NGW) {
        int r = it;
        if (r < I_IN) { p0_transpose_item(C.w_in, DM, NIN, (bf16_t*)(C.ws + WS_WIN), 1, nullptr, scr, r, lane); continue; } r -= I_IN;
        if (r < 3 * I_BR) { const int z = r / I_BR; p0_transpose_item(C.w_br + (size_t)z * 1024 * DM, 1024, DM, (bf16_t*)(C.ws + WS_WBR) + (size_t)z * DM * 1024, 0, nullptr, scr, r % I_BR, lane); continue; } r -= 3 * I_BR;
        if (r < I_O) { p0_transpose_item(C.w_o, DM, DM, (bf16_t*)(C.ws + WS_WO), 0, nullptr, scr, r, lane); continue; } r -= I_O;
        if (r < I_MEM) { p0_transpose_item(C.w_mem, DM, DM, (bf16_t*)(C.ws + WS_WMEM), 0, nullptr, scr, r, lane); continue; } r -= I_MEM;
        if (r < I_UP) { p0_transpose_item(C.w_up, DM, FF2, (bf16_t*)(C.ws + WS_WUP), 2, C.g_ffn, scr, r, lane); continue; } r -= I_UP;
        p0_transpose_item(C.w_down, FF, DM, (bf16_t*)(C.ws + WS_WDN), 0, nullptr, scr, r, lane, FFP);
    }
    (void)ws16;
    bf16_t* U = (bf16_t*)C.out;
    {
        f32x4 gmix[8];
#pragma unroll
        for (int j = 0; j < 8; ++j) gmix[j] = *((const f32x4*)C.g_mix + lane + 64 * j);
        for (int m = gw; m < MT; m += NGW) rms_row_to_bf16_g(m < MP ? C.xp + (size_t)m * DM : C.xs + (size_t)(m - MP) * DM, gmix, U + (size_t)m * DM, lane);
        for (int m = gw; m < 1024; m += NGW) rms_row_to_bf16(C.memp + (size_t)m * DM, C.g_mem, (bf16_t*)(C.ws + WS_MEMN) + (size_t)m * DM, lane);
    }
    for (int i = gt; i < 2 * 8 * 256 * 128; i += NGT) { const int which = i >= 8 * 256 * 128, e = (i - which * 8 * 256 * 128) * 8;
        const float* src = (which ? C.cmemv : C.cmemk) + e; bf16_t* dst = (bf16_t*)(C.ws + (which ? WS_MV : WS_MK)) + (size_t)1024 * 1024 + e;
        store8bf(dst, *(const f32x4*)src, *(const f32x4*)(src + 4)); }
    for (int i = gt; i < 2 * 8 * 64 * 64; i += NGT) { const int which = i >= 8 * 64 * 64, j = i - which * 8 * 64 * 64, b = j >> 12, rem = j & 4095;
        const float* src = (which ? C.cswav : C.cswak) + ((size_t)b * 128 + 64) * 256 + rem * 4; float* dst = C.out + (which ? O_SWAV_S : O_SWAK_S) + (size_t)b * 128 * 256 + rem * 4;
        *(f32x4*)dst = *(const f32x4*)src; }
    for (int i = gt; i < 64 * 128 * 128; i += NGT) { const int bh = i >> 14, e = (i >> 7) & 127, p = i & 127;
        ((bf16_t*)(C.ws + WS_S0T))[i] = (bf16_t)(cvtpk(C.sret[((size_t)bh * 128 + dorig(p)) * 128 + e], 0.f) & 0xffffu); }
    float* ss = (float*)(C.ws + WS_CTL);
    for (int i = gt; i < 2 * MT; i += NGT) ss[i] = 0.f;
    if (gt == 0) { if (first) *(unsigned*)(C.ws + WS_BAR) = 0u; *(unsigned*)(C.ws + WS_BAR + 256) = 0u; *(unsigned*)(C.ws + WS_BAR + 512) = 0u; }
}

#define MFMA32(a, b, c) __builtin_amdgcn_mfma_f32_32x32x16_bf16((a), (b), (c), 0, 0, 0)
typedef short v4i16_t __attribute__((ext_vector_type(4)));
DI s16x4 tr_read(const LAS unsigned char* p) { return __builtin_bit_cast(s16x4, __builtin_amdgcn_ds_read_tr16_b64_v4i16((LAS v4i16_t*)p)); }
DI bf16x8 tr_pair(const LAS unsigned char* tile, int stride, int rlo, int rhi, int col0, int lane) {
    const int q4 = (lane & 15) >> 2, p = lane & 3, blk = (lane >> 4) & 1;
    const s16x4 lo = tr_read(tile + (rlo + q4) * stride + (col0 + 16 * blk + 4 * p) * 2);
    const s16x4 hi = tr_read(tile + (rhi + q4) * stride + (col0 + 16 * blk + 4 * p) * 2);
    return __builtin_shufflevector(lo, hi, 0, 1, 2, 3, 4, 5, 6, 7);
}
DI bf16x8 pack_step(const f32x16& x, int s) {
    u32x4 p; p.x = cvtpk(x[8 * s], x[8 * s + 1]); p.y = cvtpk(x[8 * s + 2], x[8 * s + 3]); p.z = cvtpk(x[8 * s + 4], x[8 * s + 5]); p.w = cvtpk(x[8 * s + 6], x[8 * s + 7]);
    return __builtin_bit_cast(bf16x8, p);
}
DI void store_pair16(bf16_t* rowp, u32x2 a, u32x2 b, int g, int hh) {
    auto r0 = __builtin_amdgcn_permlane32_swap(a.x, b.x, false, false); a.x = r0[0]; b.x = r0[1];
    auto r1 = __builtin_amdgcn_permlane32_swap(a.y, b.y, false, false); a.y = r1[0]; b.y = r1[1];
    *(u32x4*)(rowp + 8 * g + 8 * hh) = (u32x4){a.x, a.y, b.x, b.y};
}
DI void store_block32(bf16_t* rowp, const f32x16& o, float sc, int hh) {
#pragma unroll
    for (int g = 0; g < 4; g += 2) {
        u32x2 a, b;
        a.x = cvtpk(o[4 * g] * sc, o[4 * g + 1] * sc); a.y = cvtpk(o[4 * g + 2] * sc, o[4 * g + 3] * sc);
        b.x = cvtpk(o[4 * g + 4] * sc, o[4 * g + 5] * sc); b.y = cvtpk(o[4 * g + 6] * sc, o[4 * g + 7] * sc);
        store_pair16(rowp, a, b, g, hh);
    }
}
DI int crow(int i, int h) { return (i & 3) + 8 * (i >> 2) + 4 * h; }
DI f32x16 zero16() { f32x16 z; for (int i = 0; i < 16; ++i) z[i] = 0.f; return z; }
DI size_t seq_rowbase(int sq) { return sq < 4 ? (size_t)sq * 8192 : (size_t)MP + (size_t)(sq - 4) * 64; }

DI void swa_unit(const Ctx& C, LAS unsigned char* lds, int sq, int hk, int c, int w) {
    const int lane = lane_id(), tid = w * 64 + lane, r = lane & 31, hh = lane >> 5;
    constexpr int KSTR = 144;
    LAS unsigned char* Kt = lds; LAS unsigned char* Vt = lds + 192 * KSTR;
    const bool samp = sq >= 4;
    const size_t rowbase = seq_rowbase(sq) + (size_t)c * 64;
    const bf16_t* KS = (const bf16_t*)(C.ws + WS_KS); const bf16_t* VS = (const bf16_t*)(C.ws + WS_VS); bf16_t* QS = (bf16_t*)(C.ws + WS_QS);
    for (int i = tid; i < 192 * 8; i += 512) {
        const int row = i >> 3, ch = i & 7, j = row >> 6, rr = row & 63;
        u32x4 kv = (u32x4){0u, 0u, 0u, 0u}, vv = kv;
        if (samp && j < 2) {
            const size_t o = (((size_t)(sq - 4) * 128 + row) * 4 + hk) * 64 + ch * 8;
            const f32x4 k0 = *(const f32x4*)(C.cswak + o), k1 = *(const f32x4*)(C.cswak + o + 4), v0 = *(const f32x4*)(C.cswav + o), v1 = *(const f32x4*)(C.cswav + o + 4);
            kv.x = cvtpk(k0[0], k0[1]); kv.y = cvtpk(k0[2], k0[3]); kv.z = cvtpk(k1[0], k1[1]); kv.w = cvtpk(k1[2], k1[3]);
            vv.x = cvtpk(v0[0], v0[1]); vv.y = cvtpk(v0[2], v0[3]); vv.z = cvtpk(v1[0], v1[1]); vv.w = cvtpk(v1[2], v1[3]);
        } else {
            const int cc = samp ? 0 : c - 2 + j;
            if (cc >= 0) { const size_t gr = seq_rowbase(sq) + (size_t)cc * 64 + rr; kv = *(const u32x4*)(KS + gr * 256 + hk * 64 + ch * 8); vv = *(const u32x4*)(VS + gr * 256 + hk * 64 + ch * 8); }
        }
        *(LAS u32x4*)(Kt + row * KSTR + ch * 16) = kv; *(LAS u32x4*)(Vt + row * KSTR + ch * 16) = vv;
    }
    const int g = w >> 1, half = w & 1, head = hk * 4 + g;
    bf16_t* qp = QS + (rowbase + 32 * half + r) * 1024 + head * 64;
    bf16x8 qf[4];
#pragma unroll
    for (int s = 0; s < 4; ++s) qf[s] = *(const bf16x8*)(qp + 16 * s + 8 * hh);
    __syncthreads();
    const int kb0 = samp ? 0 : (c >= 2 ? 0 : (2 - c) * 2);
    f32x16 acc[6];
#pragma unroll
    for (int kb = 0; kb < 6; ++kb) { acc[kb] = zero16();
        if (kb >= kb0) {
#pragma unroll
            for (int s = 0; s < 4; ++s) { const bf16x8 a = *(const LAS bf16x8*)(Kt + (32 * kb + r) * KSTR + (16 * s + 8 * hh) * 2); acc[kb] = MFMA32(a, qf[s], acc[kb]); } } }
    const float sk = C.sink[head] * LOG2E;
    float mx = sk;
#pragma unroll
    for (int kb = 0; kb < 6; ++kb) if (kb >= kb0) {
#pragma unroll
        for (int i = 0; i < 16; ++i) mx = fmaxf(mx, acc[kb][i]); }
    mx = fmaxf(mx, __shfl_xor(mx, 32));
    float l = 0.f;
#pragma unroll
    for (int kb = 0; kb < 6; ++kb) if (kb >= kb0) {
#pragma unroll
        for (int i = 0; i < 16; ++i) { const float p = fexp2(acc[kb][i] - mx); acc[kb][i] = p; l += p; } }
    l += __shfl_xor(l, 32); l += fexp2(sk - mx);
    f32x16 o[2]; o[0] = zero16(); o[1] = zero16();
#pragma unroll
    for (int kb = 0; kb < 6; ++kb) if (kb >= kb0) {
#pragma unroll
        for (int s = 0; s < 2; ++s) { const bf16x8 pb = pack_step(acc[kb], s); const int r0 = 32 * kb + 16 * s + 4 * hh;
#pragma unroll
            for (int db = 0; db < 2; ++db) { const bf16x8 a = tr_pair(Vt, KSTR, r0, r0 + 8, 32 * db, lane); o[db] = MFMA32(a, pb, o[db]); } } }
    const float inv = 1.0f / l;
#pragma unroll
    for (int db = 0; db < 2; ++db) store_block32(qp + 32 * db, o[db], inv, hh);
    __syncthreads();
}

DI void mem_unit(const Ctx& C, LAS unsigned char* lds, int sq, int h, int qt, int w) {
    const int lane = lane_id(), tid = w * 64 + lane, r = lane & 31, hh = lane >> 5;
    constexpr int MSTR = 272;
    const bool samp = sq >= 4;
    const size_t qrow = samp ? seq_rowbase(sq) + 32 * (w & 1) + r : seq_rowbase(sq) + (size_t)qt * 256 + 32 * w + r;
    const bool do_store = !samp || w < 2;
    bf16_t* qp = (bf16_t*)(C.ws + WS_QM) + qrow * 1024 + h * 256;
    const bf16_t* Kg = (const bf16_t*)(C.ws + WS_MK) + (size_t)sq * 256 * 1024 + h * 256; const bf16_t* Vg = (const bf16_t*)(C.ws + WS_MV) + (size_t)sq * 256 * 1024 + h * 256;
    f32x16 acc[8];
#pragma unroll
    for (int mb = 0; mb < 8; ++mb) acc[mb] = zero16();
#pragma unroll 1
    for (int dh = 0; dh < 2; ++dh) {
        __syncthreads();
        for (int i = tid; i < 256 * 16; i += 512) { const int row = i >> 4, ch = i & 15; *(LAS u32x4*)(lds + row * MSTR + ch * 16) = *(const u32x4*)(Kg + (size_t)row * 1024 + dh * 128 + ch * 8); }
        bf16x8 qf[8];
#pragma unroll
        for (int s = 0; s < 8; ++s) qf[s] = *(const bf16x8*)(qp + dh * 128 + 16 * s + 8 * hh);
        __syncthreads();
#pragma unroll
        for (int mb = 0; mb < 8; ++mb)
#pragma unroll
            for (int s = 0; s < 8; ++s) { const bf16x8 a = *(const LAS bf16x8*)(lds + (32 * mb + r) * MSTR + (16 * s + 8 * hh) * 2); acc[mb] = MFMA32(a, qf[s], acc[mb]); }
    }
    float mx = -3.0e38f;
#pragma unroll
    for (int mb = 0; mb < 8; ++mb)
#pragma unroll
        for (int i = 0; i < 16; ++i) mx = fmaxf(mx, acc[mb][i]);
    mx = fmaxf(mx, __shfl_xor(mx, 32));
    float l = 0.f; bf16x8 pb[16];
#pragma unroll
    for (int mb = 0; mb < 8; ++mb) {
#pragma unroll
        for (int i = 0; i < 16; ++i) { const float p = fexp2(acc[mb][i] - mx); acc[mb][i] = p; l += p; }
        pb[2 * mb] = pack_step(acc[mb], 0); pb[2 * mb + 1] = pack_step(acc[mb], 1); }
    l += __shfl_xor(l, 32);
    const float inv = 1.0f / l;
#pragma unroll 1
    for (int dh = 0; dh < 2; ++dh) {
        __syncthreads();
        for (int i = tid; i < 256 * 16; i += 512) { const int row = i >> 4, ch = i & 15; *(LAS u32x4*)(lds + row * MSTR + ch * 16) = *(const u32x4*)(Vg + (size_t)row * 1024 + dh * 128 + ch * 8); }
        __syncthreads();
        f32x16 o[4];
#pragma unroll
        for (int db = 0; db < 4; ++db) o[db] = zero16();
#pragma unroll
        for (int ks = 0; ks < 16; ++ks) { const int r0 = 32 * (ks >> 1) + 16 * (ks & 1) + 4 * hh;
#pragma unroll
            for (int db = 0; db < 4; ++db) { const bf16x8 a = tr_pair(lds, MSTR, r0, r0 + 8, 32 * db, lane); o[db] = MFMA32(a, pb[ks], o[db]); } }
        if (do_store) {
#pragma unroll
            for (int db = 0; db < 4; ++db) store_block32(qp + dh * 128 + 32 * db, o[db], inv, hh); }
    }
    __syncthreads();
}

DI bf16_t* ut_ptr(const Ctx& C, int sq, int h, int c) { const size_t idx = sq < 4 ? ((size_t)(sq * 8 + h) * 128 + c) : (size_t)4096 + (size_t)(sq - 4) * 8 + h; return (bf16_t*)C.out + idx * 16384; }
DI void stage_rows128(LAS unsigned char* dst, const bf16_t* src, int nrows, int tid) {
    for (int i = tid; i < nrows * 16; i += 512) { const int row = i >> 4, ch = i & 15; *(LAS u32x4*)(dst + row * 272 + ch * 16) = *(const u32x4*)(src + (size_t)row * 1024 + ch * 8); }
}
DI void retA_unit(const Ctx& C, LAS unsigned char* lds, int sq, int h, int c, int w) {
    const int lane = lane_id(), tid = w * 64 + lane, r = lane & 31, hh = lane >> 5;
    constexpr int RSTR = 272;
    LAS unsigned char* Kt = lds; LAS unsigned char* Vt = lds + 64 * RSTR;
    const size_t rowbase = seq_rowbase(sq) + (size_t)c * 64;
    stage_rows128(Kt, (const bf16_t*)(C.ws + WS_KR) + rowbase * 1024 + h * 128, 64, tid);
    stage_rows128(Vt, (const bf16_t*)(C.ws + WS_VR) + rowbase * 1024 + h * 128, 64, tid);
    __syncthreads();
    const int eb = w >> 1, db0 = (w & 1) * 2;
    f32x16 acc[2]; acc[0] = zero16(); acc[1] = zero16();
#pragma unroll
    for (int s = 0; s < 4; ++s) { const int r0 = 16 * s + 8 * hh;
        const bf16x8 b = tr_pair(Vt, RSTR, r0, r0 + 4, 32 * eb, lane);
#pragma unroll
        for (int x = 0; x < 2; ++x) { const bf16x8 a = tr_pair(Kt, RSTR, r0, r0 + 4, 32 * (db0 + x), lane); acc[x] = MFMA32(a, b, acc[x]); } }
    bf16_t* U = ut_ptr(C, sq, h, c) + (size_t)(32 * eb + r) * 128;
#pragma unroll
    for (int x = 0; x < 2; ++x) store_block32(U + 32 * (db0 + x), acc[x], 1.0f, hh);
    __syncthreads();
}

DI void ret_scan(const Ctx& C, int wave) {
    const int tid = wave * 64 + lane_id();
    const int gt = blockIdx.x * 512 + tid, NGT = gridDim.x * 512;
    for (int it = gt; it < 32 * 4096 + 64 * 4096; it += NGT) {
        if (it < 32 * 4096) {
            const int bh = it >> 12, e = (it >> 5) & 127, p0 = (it & 31) * 4, h = bh & 7;
            const float g64 = fexp2(64.f * log2gamma(h));
            bf16_t* U = (bf16_t*)C.out + (size_t)bh * 128 * 16384 + e * 128 + p0;
            float s0 = 0.f, s1 = 0.f, s2 = 0.f, s3 = 0.f;
#pragma unroll 1
            for (int c0 = 0; c0 < 128; c0 += 16) {
                u32x2 u[16];
#pragma unroll
                for (int k = 0; k < 16; ++k) u[k] = *(const u32x2*)(U + (size_t)(c0 + k) * 16384);
#pragma unroll
                for (int k = 0; k < 16; ++k) { s0 = g64 * (s0 + bflo(u[k].x)); s1 = g64 * (s1 + bfhi(u[k].x)); s2 = g64 * (s2 + bflo(u[k].y)); s3 = g64 * (s3 + bfhi(u[k].y));
                    u32x2 wv; wv.x = cvtpk(s0, s1); wv.y = cvtpk(s2, s3); *(u32x2*)(U + (size_t)(c0 + k) * 16384) = wv; }
            }
            float* O = C.out + O_RET_P + (size_t)bh * 16384 + e;
            O[(size_t)dorig(p0) * 128] = s0; O[(size_t)dorig(p0 + 1) * 128] = s1; O[(size_t)dorig(p0 + 2) * 128] = s2; O[(size_t)dorig(p0 + 3) * 128] = s3;
        } else {
            const int j = it - 32 * 4096, bh = j >> 12, e = (j >> 5) & 127, p0 = (j & 31) * 4, h = bh & 7;
            const float g64 = fexp2(64.f * log2gamma(h));
            const u32x2 u = *(const u32x2*)((const bf16_t*)C.out + ((size_t)4096 + bh) * 16384 + e * 128 + p0);
            const float uu[4] = {bflo(u.x), bfhi(u.x), bflo(u.y), bfhi(u.y)};
#pragma unroll
            for (int k = 0; k < 4; ++k) { const size_t o = ((size_t)bh * 128 + dorig(p0 + k)) * 128 + e; C.out[O_RET_S + o] = g64 * (C.sret[o] + uu[k]); }
        }
    }
}

struct RetCRegs { u32x4 kvq[6]; u32x4 st[4]; };
DI void retC_decode(int u, int& sq, int& h, int& c) { if (u < 4096) { sq = u >> 10; h = (u >> 7) & 7; c = u & 127; } else { const int x = u - 4096; sq = 4 + (x >> 3); h = x & 7; c = 0; } }
DI void retC_get(const Ctx& C, int u, int tid, RetCRegs& R) {
    int sq, h, c; retC_decode(u, sq, h, c);
    const size_t rowbase = seq_rowbase(sq) + (size_t)c * 64; const bool samp = sq >= 4, has_prev = samp || c > 0;
    const bf16_t* Kg = (const bf16_t*)(C.ws + WS_KR) + rowbase * 1024 + h * 128; const bf16_t* Vg = (const bf16_t*)(C.ws + WS_VR) + rowbase * 1024 + h * 128; const bf16_t* Qg = (const bf16_t*)(C.ws + WS_QR) + rowbase * 1024 + h * 128;
#pragma unroll
    for (int k = 0; k < 2; ++k) { const int i = tid + 512 * k, row = i >> 4, ch = i & 15; const size_t o = (size_t)row * 1024 + ch * 8;
        R.kvq[k] = *(const u32x4*)(Kg + o); R.kvq[2 + k] = *(const u32x4*)(Vg + o); R.kvq[4 + k] = *(const u32x4*)(Qg + o); }
    if (has_prev) { const bf16_t* S = samp ? (const bf16_t*)(C.ws + WS_S0T) + (size_t)((sq - 4) * 8 + h) * 16384 : ut_ptr(C, sq, h, c - 1);
#pragma unroll
        for (int k = 0; k < 4; ++k) { const int i = tid + 512 * k, row = i >> 4, ch = i & 15; R.st[k] = *(const u32x4*)(S + (size_t)row * 128 + ch * 8); } }
    else {
#pragma unroll
        for (int k = 0; k < 4; ++k) R.st[k] = (u32x4){0u, 0u, 0u, 0u}; }
}
DI void retC_put(LAS unsigned char* lds, int tid, const RetCRegs& R) {
    constexpr int RSTR = 272;
#pragma unroll
    for (int k = 0; k < 2; ++k) { const int i = tid + 512 * k, row = i >> 4, ch = i & 15;
        *(LAS u32x4*)(lds + row * RSTR + ch * 16) = R.kvq[k]; *(LAS u32x4*)(lds + (64 + row) * RSTR + ch * 16) = R.kvq[2 + k]; *(LAS u32x4*)(lds + (128 + row) * RSTR + ch * 16) = R.kvq[4 + k]; }
#pragma unroll
    for (int k = 0; k < 4; ++k) { const int i = tid + 512 * k, row = i >> 4, ch = i & 15; *(LAS u32x4*)(lds + (192 + row) * RSTR + ch * 16) = R.st[k]; }
}
DI void retC_unit(const Ctx& C, LAS unsigned char* lds, int sq, int h, int c, int w) {
    const int lane = lane_id(), tid = w * 64 + lane, r = lane & 31, hh = lane >> 5;
    constexpr int RSTR = 272;
    LAS unsigned char* Kt = lds; LAS unsigned char* Vt = lds + 64 * RSTR; LAS unsigned char* Qt = lds + 128 * RSTR; LAS unsigned char* St = lds + 192 * RSTR;
    LAS float* red = (LAS float*)(lds + 320 * RSTR);
    const size_t rowbase = seq_rowbase(sq) + (size_t)c * 64;
    const bool samp = sq >= 4, has_prev = samp || c > 0;
    bf16_t* QR = (bf16_t*)(C.ws + WS_QR);
    const int nh = w & 1, eq = w >> 1;
    bf16x8 qf[8];
#pragma unroll
    for (int s = 0; s < 8; ++s) qf[s] = *(const LAS bf16x8*)(Qt + (32 * nh + r) * RSTR + (16 * s + 8 * hh) * 2);
    f32x16 o = zero16();
#pragma unroll
    for (int mb = 0; mb < 2; ++mb) if (mb <= nh) {
        f32x16 P = zero16();
#pragma unroll
        for (int s = 0; s < 8; ++s) { const bf16x8 a = *(const LAS bf16x8*)(Kt + (32 * mb + r) * RSTR + (16 * s + 8 * hh) * 2); P = MFMA32(a, qf[s], P); }
        if (mb == nh) {
#pragma unroll
            for (int i = 0; i < 16; ++i) if (crow(i, hh) > r) P[i] = 0.f; }
#pragma unroll
        for (int s = 0; s < 2; ++s) { const bf16x8 pb = pack_step(P, s); const int r0 = 32 * mb + 16 * s + 4 * hh; const bf16x8 a = tr_pair(Vt, RSTR, r0, r0 + 8, 32 * eq, lane); o = MFMA32(a, pb, o); }
    }
    if (has_prev) {
#pragma unroll
        for (int s = 0; s < 8; ++s) { const bf16x8 a = *(const LAS bf16x8*)(St + (32 * eq + r) * RSTR + (16 * s + 8 * hh) * 2); o = MFMA32(a, qf[s], o); } }
    float ss = 0.f;
#pragma unroll
    for (int i = 0; i < 16; ++i) ss += o[i] * o[i];
    ss += __shfl_xor(ss, 32);
    if (hh == 0) red[(32 * nh + r) * 4 + eq] = ss;
    __syncthreads();
    const f32x4 rr = *(const LAS f32x4*)(red + (32 * nh + r) * 4);
    const float rstd = rsqrtf(((rr[0] + rr[1]) + (rr[2] + rr[3])) * (1.0f / 128.0f) + EPS);
    const size_t orow = (rowbase + 32 * nh + r) * 1024 + h * 128 + 32 * eq;
    const bf16_t* GR = (const bf16_t*)(C.ws + WS_GR);
    u32x2 gt[4];
#pragma unroll
    for (int g4 = 0; g4 < 4; ++g4) gt[g4] = *(const u32x2*)(GR + orow + 8 * g4 + 4 * hh);
#pragma unroll
    for (int g = 0; g < 4; g += 2) { u32x2 a, b;
        a.x = cvtpk(o[4 * g] * rstd * bflo(gt[g].x), o[4 * g + 1] * rstd * bfhi(gt[g].x)); a.y = cvtpk(o[4 * g + 2] * rstd * bflo(gt[g].y), o[4 * g + 3] * rstd * bfhi(gt[g].y));
        b.x = cvtpk(o[4 * g + 4] * rstd * bflo(gt[g + 1].x), o[4 * g + 5] * rstd * bfhi(gt[g + 1].x)); b.y = cvtpk(o[4 * g + 6] * rstd * bflo(gt[g + 1].y), o[4 * g + 7] * rstd * bfhi(gt[g + 1].y));
        store_pair16(QR + orow, a, b, g, hh); }
    __syncthreads();
}

DI void conv_fixup(const Ctx& C, int wave) {
    const int tid = wave * 64 + lane_id();
    const int gt = blockIdx.x * 512 + tid;
    const float* RAW = (const float*)(C.ws + WS_RAW); bf16_t* ACT = (bf16_t*)(C.ws + WS_ACT);
    constexpr int F4 = FF / 4;
    const int fc = gt % F4, g0 = gt / F4, f = fc * 4;
    f32x4 w0[2], w1[2], w2[2], bb[2];
#pragma unroll
    for (int gv = 0; gv < 2; ++gv) { w0[gv] = *(const f32x4*)(C.w_conv + gv * FF + f); w1[gv] = *(const f32x4*)(C.w_conv + FF2 + gv * FF + f); w2[gv] = *(const f32x4*)(C.w_conv + 2 * FF2 + gv * FF + f); bb[gv] = *(const f32x4*)(C.b_conv + gv * FF + f); }
    for (int grp = g0; grp < 512; grp += 93) {
        if ((grp & 127) == 0) continue;
        const float* cur = RAW + (size_t)grp * 4 * 2 * FF + f; const float* prv = RAW + (size_t)(grp - 1) * 4 * 2 * FF + f;
        f32x4 c0[2], c1[2];
#pragma unroll
        for (int gv = 0; gv < 2; ++gv) {
            const f32x4 p62 = *(const f32x4*)(prv + (size_t)(2 * 2 + gv) * FF), p63 = *(const f32x4*)(prv + (size_t)(3 * 2 + gv) * FF), a0 = *(const f32x4*)(cur + (size_t)(0 * 2 + gv) * FF), a1 = *(const f32x4*)(cur + (size_t)(1 * 2 + gv) * FF);
            c0[gv] = bb[gv] + w0[gv] * p62 + w1[gv] * p63 + w2[gv] * a0; c1[gv] = bb[gv] + w0[gv] * p63 + w1[gv] * a0 + w2[gv] * a1;
        }
        u32x2 o0, o1;
        o0.x = cvtpk(silu_f(c0[0][0]) * c0[1][0], silu_f(c0[0][1]) * c0[1][1]); o0.y = cvtpk(silu_f(c0[0][2]) * c0[1][2], silu_f(c0[0][3]) * c0[1][3]);
        o1.x = cvtpk(silu_f(c1[0][0]) * c1[1][0], silu_f(c1[0][1]) * c1[1][1]); o1.y = cvtpk(silu_f(c1[0][2]) * c1[1][2], silu_f(c1[0][3]) * c1[1][3]);
        *(u32x2*)(ACT + (size_t)(grp * 64) * FFP + f) = o0; *(u32x2*)(ACT + (size_t)(grp * 64 + 1) * FFP + f) = o1;
    }
}

DI void conv_merged_s(const Ctx& C, int wave) {
    const int gw = blockIdx.x * 8 + wave, lane = lane_id();
    if (gw < MS) {
        const f32x4* s = (const f32x4*)C.out + (size_t)gw * (DM / 4); u32x2* d = (u32x2*)((bf16_t*)(C.ws + WS_MERGED) + (size_t)(MP + gw) * DM);
#pragma unroll
        for (int j = 0; j < 8; ++j) { f32x4 v = s[lane + 64 * j];
#pragma unroll
            for (int q = 1; q < 6; ++q) v += s[(size_t)q * (MS * DM / 4) + lane + 64 * j];
            u32x2 w; w.x = cvtpk(v[0], v[1]); w.y = cvtpk(v[2], v[3]); d[lane + 64 * j] = w; }
        asm volatile("s_waitcnt vmcnt(0)" ::: "memory");
        __builtin_amdgcn_fence(__ATOMIC_RELEASE, "agent");
        if (lane == 0) __hip_atomic_fetch_add((unsigned*)(C.ws + WS_BAR + 256), 1u, __ATOMIC_RELAXED, __HIP_MEMORY_SCOPE_AGENT);
    }
}
DI void conv_h_s(const Ctx& C, int wave) {
    const int gw = blockIdx.x * 8 + wave, lane = lane_id();
    if (gw < MS) {
        const f32x4* s = (const f32x4*)C.out + (size_t)gw * (DM / 4); const f32x4* x = (const f32x4*)C.xs + (size_t)gw * (DM / 4);
        f32x4* h = (f32x4*)(C.out + (size_t)(MP + gw) * DM); u32x2* d = (u32x2*)((bf16_t*)(C.ws + WS_H1B) + (size_t)(MP + gw) * DM); float ss = 0.f;
#pragma unroll
        for (int j = 0; j < 8; ++j) { f32x4 v = x[lane + 64 * j];
#pragma unroll
            for (int q = 0; q < 4; ++q) v += s[(size_t)q * (MS * DM / 4) + lane + 64 * j];
            h[lane + 64 * j] = v; u32x2 w; w.x = cvtpk(v[0], v[1]); w.y = cvtpk(v[2], v[3]); d[lane + 64 * j] = w; ss += (v[0] * v[0] + v[1] * v[1]) + (v[2] * v[2] + v[3] * v[3]); }
        ss = wave_sum(ss);
        if (lane == 0) ((float*)(C.ws + WS_CTL))[MP + gw] = ss;
        asm volatile("s_waitcnt vmcnt(0)" ::: "memory");
        __builtin_amdgcn_fence(__ATOMIC_RELEASE, "agent");
        if (lane == 0) __hip_atomic_fetch_add((unsigned*)(C.ws + WS_BAR + 512), 1u, __ATOMIC_RELAXED, __HIP_MEMORY_SCOPE_AGENT);
    }
}
DI void final_norm(const Ctx& C, int wave) {
    const int lane = lane_id();
    const int gw = blockIdx.x * 8 + wave, NGW = gridDim.x * 8;
    f32x4 gfin[8];
#pragma unroll
    for (int j = 0; j < 8; ++j) gfin[j] = *((const f32x4*)C.g_final + lane + 64 * j);
    for (int m = gw; m < MT; m += NGW) {
        f32x4* row = (f32x4*)(C.out + (size_t)m * DM);
        f32x4 v[8]; float s = 0.f;
        if (m < MP) {
            const u32x2* hb = (const u32x2*)((const bf16_t*)(C.ws + WS_H1B) + (size_t)m * DM);
#pragma unroll
            for (int j = 0; j < 8; ++j) { const u32x2 h = hb[lane + 64 * j]; v[j] = (f32x4){bflo(h.x), bfhi(h.x), bflo(h.y), bfhi(h.y)}; }
        } else {
            const f32x4* pd = (const f32x4*)(C.ws + WS_VR) + (size_t)(m - MP) * (DM / 4);
#pragma unroll
            for (int j = 0; j < 8; ++j) { v[j] = row[lane + 64 * j];
#pragma unroll
                for (int q = 0; q < 11; ++q) v[j] += pd[(size_t)q * (MS * DM / 4) + lane + 64 * j]; }
        }
#pragma unroll
        for (int j = 0; j < 8; ++j) s += (v[j][0] * v[j][0] + v[j][1] * v[j][1]) + (v[j][2] * v[j][2] + v[j][3] * v[j][3]);
        const float rstd = rsqrtf(wave_sum(s) * (1.0f / DM) + EPS);
#pragma unroll
        for (int j = 0; j < 8; ++j) row[lane + 64 * j] = v[j] * rstd * gfin[j];
    }
}

#define XB_TMO      128
#define XB_XCNT(j)  (256  + 64 * (j))
#define XB_XSUB(j)  (1280 + 64 * (j))
#define XB_XGEN(j)  (2304 + 64 * (j))
#define XB_TOP      3328
#define XB_TOPGEN   3392
#define XCD_BAR_WORDS 3456
#define XB_SPIN_CAP (1u << 18)
constexpr size_t WS_XBAR = 768 * 1024;
DI unsigned xb_ld(unsigned* p)              { return __hip_atomic_load(p, __ATOMIC_RELAXED, __HIP_MEMORY_SCOPE_AGENT); }
DI unsigned xb_add(unsigned* p, unsigned v) { return __hip_atomic_fetch_add(p, v, __ATOMIC_RELAXED, __HIP_MEMORY_SCOPE_AGENT); }
DI unsigned xb_xcc_id() { return (unsigned)__builtin_amdgcn_s_getreg((3 << 11) | 20) & 0xFu; }
#define XB_SPIN(cond, bar) do { unsigned _sp = 0; while (cond) { __builtin_amdgcn_s_sleep(1); \
    if ((++_sp & 255u) == 0u) { if (xb_ld(&(bar)[XB_TMO])) break; if (_sp > XB_SPIN_CAP) { atomicAdd(&(bar)[XB_TMO], 1u); break; } } } } while (0)
struct XcdBarrier { unsigned* bar; unsigned x; volatile LAS unsigned* st; };
DI void xcd_barrier_complete(unsigned* bar, unsigned x, unsigned& nloc, unsigned& nx) {
    const unsigned G = gridDim.x;
    unsigned sum, cnt, mine, sp = 0u;
    for (;;) {
        sum = 0u; cnt = 0u; mine = 0u;
#pragma unroll
        for (unsigned j = 0; j < 16; ++j) { const unsigned c = xb_ld(&bar[XB_XCNT(j)]); sum += c; cnt += (c > 0u) ? 1u : 0u; mine = (j == x) ? c : mine; }
        if (sum == G) break;
        __builtin_amdgcn_s_sleep(1);
        if ((++sp & 255u) == 0u) { if (xb_ld(&bar[XB_TMO])) break; if (sp > XB_SPIN_CAP) { atomicAdd(&bar[XB_TMO], 1u); break; } }
    }
    nloc = mine > 0u ? mine : 1u; nx = cnt > 0u ? cnt : 1u;
}
DI void xcd_barrier(const XcdBarrier& b, int wave) {
    asm volatile("s_waitcnt vmcnt(0)" ::: "memory");
    __syncthreads();
    if (wave == 0 && lane_id() == 0) {
        unsigned* bar = b.bar;
        __builtin_amdgcn_s_waitcnt(0);
        unsigned nloc = b.st[0], nx = b.st[1];
        if (nloc == 0u) { xcd_barrier_complete(bar, b.x, nloc, nx); b.st[0] = nloc; b.st[1] = nx; }
        const unsigned old = xb_add(&bar[XB_XSUB(b.x)], 1u);
        const unsigned gen = old / nloc;
        if (old + 1u == (gen + 1u) * nloc) {
            __builtin_amdgcn_fence(__ATOMIC_RELEASE, "agent");
            asm volatile("s_waitcnt vmcnt(0)" ::: "memory");
            const unsigned og = xb_add(&bar[XB_TOP], 1u);
            const unsigned tg = og / nx;
            if (og + 1u == (tg + 1u) * nx) xb_add(&bar[XB_TOPGEN], 1u);
            else XB_SPIN(xb_ld(&bar[XB_TOPGEN]) == tg, bar);
            __builtin_amdgcn_fence(__ATOMIC_ACQUIRE, "agent");
            xb_add(&bar[XB_XGEN(b.x)], 1u);
            asm volatile("s_waitcnt vmcnt(0)" ::: "memory");
        } else {
            XB_SPIN(xb_ld(&bar[XB_XGEN(b.x)]) == gen, bar);
            __builtin_amdgcn_fence(__ATOMIC_ACQUIRE, "agent");
            asm volatile("s_waitcnt vmcnt(0)" ::: "memory");
        }
    }
    __syncthreads();
}

constexpr int LDS_BYTES = 147456;
#define MKCTX Ctx C; C.xp = args.in[0]; C.xs = args.in[1]; C.memp = args.in[2]; C.cswak = args.in[3]; C.cswav = args.in[4]; C.sret = args.in[5]; C.sconv = args.in[6]; C.cmemk = args.in[7]; C.cmemv = args.in[8]; C.g_mix = args.in[9]; C.w_in = args.in[10]; C.b_gate = args.in[11]; C.sink = args.in[12]; C.w_br = args.in[13]; C.w_o = args.in[14]; C.g_mem = args.in[15]; C.w_mem = args.in[16]; C.g_ffn = args.in[17]; C.w_up = args.in[18]; C.w_conv = args.in[19]; C.b_conv = args.in[20]; C.w_down = args.in[21]; C.g_final = args.in[22]; C.out = args.out; C.ws = args.ws;
__global__ void __launch_bounds__(512, 2) fwd(Args args) {
    extern __shared__ __attribute__((aligned(16))) unsigned char lds_raw[];
    LAS unsigned char* lds = (LAS unsigned char*)lds_raw;
    cg::grid_group grid = cg::this_grid();
    const int wave = __builtin_amdgcn_readfirstlane(threadIdx.x >> 6);
    XcdBarrier xbar; xbar.bar = (unsigned*)(args.ws + WS_XBAR); xbar.x = xb_xcc_id(); xbar.st = (volatile LAS unsigned*)(lds + 131072 + 64);
    if (wave == 0 && lane_id() == 0) { xbar.st[0] = 0u; xbar.st[1] = 0u; (void)xb_add(&xbar.bar[XB_XCNT(xbar.x)], 1u); }
    __syncthreads();
#ifndef PROBE_PREFIX
#define PROBE_PREFIX 0
#endif
    const int G = gridDim.x, bid = blockIdx.x;
    for (int pass = (PROBE_PREFIX ? 0 : 1); pass < 2; ++pass) {
    const int lo = 0, hi = (pass == 0) ? PROBE_PREFIX : 11;
#ifndef PH_MASK
#define PH_MASK 0x7ff
#endif
#define IN(k) (((PH_MASK >> (k)) & 1) && lo <= (k) && (k) < hi)
#ifndef REP_MASK
#define REP_MASK 0
#endif
#define SEAM(k) do { if (!IN(k)) break; if ((k) == 0) grid.sync(); else xcd_barrier(xbar, wave); } while (0)
#define NREP(k) (1 + ((REP_MASK >> (k)) & 1))
    if (IN(0)) { MKCTX; p0_prologue(C, lds, wave, pass == (PROBE_PREFIX ? 0 : 1)); }
    SEAM(0);
    if (IN(1)) {
        MKCTX;
        SchedP1 S{(const char*)C.out, (const char*)(C.ws + WS_WIN), (const char*)(C.ws + WS_MEMN), (const char*)(C.ws + WS_WMEM), G, bid};
        EpiP1 E{(bf16_t*)(C.ws + WS_QS), (bf16_t*)(C.ws + WS_KS), (bf16_t*)(C.ws + WS_VS), (bf16_t*)(C.ws + WS_QR), (bf16_t*)(C.ws + WS_KR), (bf16_t*)(C.ws + WS_VR), (bf16_t*)(C.ws + WS_GR),
                (bf16_t*)(C.ws + WS_QM), (bf16_t*)(C.ws + WS_GT), (bf16_t*)(C.ws + WS_MK), (bf16_t*)(C.ws + WS_MV), C.b_gate, C.out};
        pg8::gemm_phase(lds, DM, S, E, wave);
    }
    SEAM(1);
    if (IN(2)) {
        MKCTX;
        constexpr int N_MEM = 544, N_SWA = 2080, N_RA = 4160;
        for (int u = bid; u < N_MEM + N_SWA + N_RA; u += G) {
            if (u < N_MEM) { if (u < 512) mem_unit(C, lds, u >> 7, (u >> 5) & 3, u & 31, wave); else { const int v = u - 512; mem_unit(C, lds, 4 + (v >> 2), v & 3, 0, wave); } }
            else if (u < N_MEM + N_SWA) { const int v = u - N_MEM; if (v < 2048) swa_unit(C, lds, v >> 9, (v >> 7) & 3, v & 127, wave); else { const int x = v - 2048; swa_unit(C, lds, 4 + (x >> 2), x & 3, 0, wave); } }
            else { const int v = u - N_MEM - N_SWA; if (v < 4096) retA_unit(C, lds, v >> 10, (v >> 7) & 7, v & 127, wave); else { const int x = v - 4096; retA_unit(C, lds, 4 + (x >> 3), x & 7, 0, wave); } }
        }
    }
    SEAM(2);
    if (IN(3)) { MKCTX; ret_scan(C, wave); }
    SEAM(3);
    if (IN(4)) {
        MKCTX;
        {
            const int tid = wave * 64 + lane_id();
            RetCRegs R;
            if (bid < 4160) retC_get(C, bid, tid, R);
            for (int u = bid; u < 4160; u += G) {
                retC_put(lds, tid, R);
                __syncthreads();
                if (u + G < 4160) retC_get(C, u + G, tid, R);
                int sq, h, c; retC_decode(u, sq, h, c);
                retC_unit(C, lds, sq, h, c, wave);
            }
        }
    }
    SEAM(4);
    if (IN(5)) {
        MKCTX;
        SchedMerge S{(const char*)(C.ws + WS_QS), (const char*)(C.ws + WS_QR), (const char*)(C.ws + WS_QM), (const char*)(C.ws + WS_WBR), G, bid};
        EpiMerge E{(const bf16_t*)(C.ws + WS_GT), (bf16_t*)(C.ws + WS_MERGED), C.out, (bf16_t*)(C.ws + WS_GR) + (size_t)bid * 65536};
        pg8::gemm_phase(lds, 1024, S, E, wave);
    }
    SEAM(5);
    if (IN(6)) {
        MKCTX;
        conv_merged_s(C, wave);
        SchedSplit<4> S{(const char*)(C.ws + WS_MERGED), (const char*)(C.ws + WS_WO), G, bid, DM, (const unsigned*)(C.ws + WS_BAR + 256), (unsigned)MS, DM};
        EpiWo E{C.xp, C.out, (bf16_t*)(C.ws + WS_H1B), (float*)(C.ws + WS_CTL)};
        pg8::gemm_phase(lds, DM, S, E, wave);
    }
    SEAM(6);
    if (IN(7)) {
        MKCTX;
        conv_h_s(C, wave);
        SchedSimple S{(const char*)(C.ws + WS_H1B), (const char*)(C.ws + WS_WUP), 130, 44, G, bid, (size_t)256 * DM * 2, 32, (const unsigned*)(C.ws + WS_BAR + 512), (unsigned)MS};
        EpiUp E{(const float*)(C.ws + WS_CTL), C.w_conv, C.b_conv, C.sconv, (bf16_t*)(C.ws + WS_ACT), (float*)(C.ws + WS_RAW), C.out, lds + 131072 + 1024};
        pg8::gemm_phase(lds, DM, S, E, wave);
    }
    SEAM(7);
    if (IN(8)) { MKCTX; conv_fixup(C, wave); }
    SEAM(8);
    if (IN(9)) {
        MKCTX;
        SchedSplit<11> S{(const char*)(C.ws + WS_ACT), (const char*)(C.ws + WS_WDN), G, bid, FF, nullptr, 0u, FFP};
        EpiDown E{(float*)(C.ws + WS_VR), (bf16_t*)(C.ws + WS_H1B)};
        pg8::gemm_phase(lds, FFP, S, E, wave);
    }
    SEAM(9);
    if (IN(10)) { MKCTX; final_norm(C, wave); }
    if (pass == 0) SEAM(10);
    }
#undef IN
#undef SEAM
}

extern "C" void kernel_launch(void* const* d_in, const int* in_sizes, int n_in, void* d_out, int out_size, void* d_ws, size_t ws_size, hipStream_t stream) {
    static int grid = 0;
    if (grid == 0) {
        if (n_in != 23 || (size_t)out_size != O_END || ws_size < WS_END) { fprintf(stderr, "kernel_launch: unexpected shapes n_in %d out %d ws %zu\n", n_in, out_size, ws_size); grid = -1; return; }
        int dev = 0, cus = 0, per_cu = 0;
        (void)hipGetDevice(&dev);
        (void)hipDeviceGetAttribute(&cus, hipDeviceAttributeMultiprocessorCount, dev);
        (void)hipFuncSetAttribute((const void*)fwd, hipFuncAttributeMaxDynamicSharedMemorySize, LDS_BYTES);
        (void)hipOccupancyMaxActiveBlocksPerMultiprocessor(&per_cu, (const void*)fwd, 512, LDS_BYTES);
        if (per_cu < 1) per_cu = 1;
        grid = cus * per_cu;
        if (grid != 256) { fprintf(stderr, "kernel_launch: this kernel is laid out for 256 workgroups (one per CU); got %d\n", grid); grid = -1; return; }
    }
    if (grid < 0) return;
    (void)hipMemsetAsync((char*)d_ws + WS_XBAR, 0, XCD_BAR_WORDS * 4, stream);
    Args a{};
    for (int i = 0; i < 23; ++i) a.in[i] = (const float*)d_in[i];
    a.out = (float*)d_out; a.ws = (unsigned char*)d_ws; a.ph_lo = 0; a.ph_hi = 11;
    void* args[] = {&a};
    hipError_t e = hipLaunchCooperativeKernel((const void*)fwd, dim3(grid), dim3(512), args, LDS_BYTES, stream);
    if (e != hipSuccess) fprintf(stderr, "cooperative launch failed: %s (grid %d)\n", hipGetErrorString(e), grid);
}
```

```cpp
#include <hip/hip_runtime.h>
#include <hip/hip_cooperative_groups.h>
#include <cstdio>
#include <cstdint>
namespace cg = cooperative_groups;

#define DI __device__ __forceinline__
#define LAS __attribute__((address_space(3)))
typedef unsigned short bf16_t;
typedef short bf16x8 __attribute__((ext_vector_type(8)));
typedef short s16x4 __attribute__((ext_vector_type(4)));
typedef float f32x4 __attribute__((ext_vector_type(4)));
typedef float f32x16 __attribute__((ext_vector_type(16)));
typedef unsigned u32x4 __attribute__((ext_vector_type(4)));
typedef unsigned u32x2 __attribute__((ext_vector_type(2)));
typedef float f32x2_t __attribute__((ext_vector_type(2)));
typedef __bf16 bf16x2_t __attribute__((ext_vector_type(2)));

constexpr int MP = 32768, MS = 512, MT = MP + MS;
constexpr int DM = 2048, NIN = 12800, FF = 5632, FF2 = 11264;
constexpr int FFP = 5696;
constexpr float EPS = 1e-6f;
constexpr float LOG2E = 1.4426950408889634f;

constexpr size_t MiB = 1u << 20;
constexpr size_t WS_BAR = 512 * 1024;
constexpr size_t WS_CTL = 0;
constexpr size_t WS_WIN = 1 * MiB;
constexpr size_t WS_WBR = 51 * MiB;
constexpr size_t WS_WO = 63 * MiB;
constexpr size_t WS_WMEM = 71 * MiB;
constexpr size_t WS_WUP = 79 * MiB;
constexpr size_t WS_WDN = 983 * MiB;
constexpr size_t WS_QS = 145 * MiB, WS_QR = 210 * MiB, WS_QM = 275 * MiB, WS_KR = 340 * MiB, WS_VR = 405 * MiB, WS_GR = 470 * MiB;
constexpr size_t WS_KS = 535 * MiB, WS_VS = WS_KS + (size_t)MT * 256 * 2;
constexpr size_t WS_GT = WS_VS + (size_t)MT * 256 * 2;
constexpr size_t WS_MK = WS_GT + (size_t)MT * 6144 * 2, WS_MV = WS_MK + 6 * MiB;
constexpr size_t WS_MEMN = WS_MV + 6 * MiB;
constexpr size_t WS_S0T = WS_MEMN + 4 * MiB;
constexpr size_t WS_MS32 = WS_S0T + 2 * MiB;
constexpr size_t WS_END = WS_MS32 + 4 * MiB;
constexpr size_t WS_MERGED = WS_KR;
constexpr size_t WS_H1B = WS_QS;
constexpr size_t WS_ACT = WS_GT;
constexpr size_t WS_RAW = WS_QM;
static_assert(WS_END <= 983 * MiB && WS_WDN + (size_t)2048 * 5696 * 2 <= 1024 * MiB, "ws map");
static_assert(WS_RAW + (size_t)128 * 4 * 4 * 2 * FF * 4 <= WS_VR, "raw rows");

constexpr size_t O_Y = 0;
constexpr size_t O_SWAK_P = (size_t)MT * DM, O_SWAV_P = O_SWAK_P + 131072, O_RET_P = O_SWAV_P + 131072, O_CONV_P = O_RET_P + 524288,
                 O_MEMK = O_CONV_P + 90112, O_MEMV = O_MEMK + 1048576, O_SWAK_S = O_MEMV + 1048576, O_SWAV_S = O_SWAK_S + 262144,
                 O_RET_S = O_SWAV_S + 262144, O_CONV_S = O_RET_S + 1048576, O_END = O_CONV_S + 180224;

struct Args {
    const float* in[23]; float* out; unsigned char* ws; int ph_lo, ph_hi;
};

struct Ctx {
    const float *xp, *xs, *memp, *cswak, *cswav, *sret, *sconv, *cmemk, *cmemv, *g_mix, *w_in, *b_gate, *sink, *w_br, *w_o, *g_mem, *w_mem, *g_ffn, *w_up, *w_conv, *b_conv, *w_down, *g_final;
    float* out; unsigned char* ws;
};

DI int lane_id() { int l; asm volatile("v_mbcnt_lo_u32_b32 %0, -1, 0\n\tv_mbcnt_hi_u32_b32 %0, -1, %0" : "=v"(l)); return l; }
DI unsigned cvtpk(float lo, float hi) { f32x2_t v = {lo, hi}; bf16x2_t b = __builtin_convertvector(v, bf16x2_t); return __builtin_bit_cast(unsigned, b); }
DI float bf2f(unsigned short h) { return __uint_as_float((unsigned)h << 16); }
DI float bflo(unsigned w) { return __uint_as_float(w << 16); }
DI float bfhi(unsigned w) { return __uint_as_float(w & 0xffff0000u); }
DI float fexp2(float x) { return __builtin_amdgcn_exp2f(x); }
DI float frcp(float x) { return __builtin_amdgcn_rcpf(x); }
DI float silu_f(float x) { return x * frcp(1.f + fexp2(-x * LOG2E)); }
DI float sigm_f(float x) { return frcp(1.f + fexp2(-x * LOG2E)); }
DI float wave_sum(float v) {
#pragma unroll
    for (int o = 1; o < 64; o <<= 1) v += __shfl_xor(v, o);
    return v;
}
DI float log2gamma(int h) { const float x = fexp2(-5.f - (float)h); return -x * (1.f + x * (0.5f + x * (0.33333334f + x * (0.25f + x * (0.2f + x * 0.16666667f))))) * LOG2E; }

namespace pg8 {
constexpr int BM = 256, BK = 64, HALF = 128, HTB = HALF * BK * 2, STAGE_BYTES = 8 * HTB, NXCD = 8, WGM = 8;
DI int lds_byte(int r, int c) { const int st = (r >> 4) * 2 + (c >> 5), rr = r & 15, cc = c & 31, ob = rr * 64 + cc * 2; return st * 1024 + (ob ^ (((ob >> 9) & 1) << 5)); }
DI void stage_rc(int b, int& R, int& C) { const int st = b / 1024, sb = b % 1024, swz = sb ^ (((sb >> 9) & 1) << 5); R = (st >> 1) * 16 + swz / 64; C = (st & 1) * 32 + (swz % 64) / 2; }
DI int perm32(int rho) { const int n = rho >> 4, i = rho & 15; return 8 * (i >> 2) + 4 * n + (i & 3); }
struct Unit { int pm, pn, z, nt, kp; };
DI void tile_map(int L, int nM, int nN, int& pm, int& pn) {
    const int nwg = nM * nN; int wgid = L;
    { const int q = nwg / NXCD, r = nwg % NXCD, xcd = wgid % NXCD, off = wgid / NXCD; wgid = (xcd < r ? xcd * (q + 1) : r * (q + 1) + (xcd - r) * q) + off; }
    const int nig = WGM * nN, gid = wgid / nig, fm = gid * WGM, gsz = (nM - fm) < WGM ? (nM - fm) : WGM;
    pm = fm + ((wgid % nig) % gsz); pn = (wgid % nig) / gsz;
}
template <class Epi, class Sched>
DI void gemm_phase(LAS unsigned char* lds, const int K, const Sched& S, const Epi& E, const int wid) {
    const int lane = lane_id(), tid = wid * 64 + lane, wr = wid >> 2, wc = wid & 3, fr = lane & 15, fq = lane >> 4;
    unsigned voffA[2], voffB[2];
#pragma unroll
    for (int i = 0; i < 2; ++i) { int R, C; stage_rc(tid * 16 + i * 8192, R, C); const int Rb = (R & ~31) + perm32(R & 31);
        voffA[i] = (unsigned)(R * K + C) * 2u; voffB[i] = (unsigned)(Rb * K + C) * 2u; }
    const size_t kstep = (size_t)(BK * 2);
    const size_t hstep = (size_t)HALF * K * 2;
    const unsigned ldsw = (unsigned)wid * 1024u;
    const int aoff = lds_byte(wr * 64 + fr, fq * 8), boff = lds_byte(wc * 32 + fr, fq * 8);
#define PG8_SA(b, h) (((b) * 2 + (h)) * HTB)
#define PG8_SB(b, h) ((4 + (b) * 2 + (h)) * HTB)
#define PG8_STAGE(bufoff, gbase, voff) do { _Pragma("unroll") for (int _i = 0; _i < 2; ++_i) \
        __builtin_amdgcn_global_load_lds((const unsigned*)((const char*)(gbase) + (voff)[_i]), (LAS unsigned*)(lds + (bufoff) + ldsw + _i * 8192), 16, 0, 0); } while (0)
#define PG8_LDA(dst, b, h) do { _Pragma("unroll") for (int m = 0; m < 4; ++m) _Pragma("unroll") for (int k = 0; k < 2; ++k) dst[m][k] = *(const LAS bf16x8*)(lds + PG8_SA(b, h) + aoff + m * 2048 + k * 1024); } while (0)
#define PG8_LDB(dst, b, h) do { _Pragma("unroll") for (int n = 0; n < 2; ++n) _Pragma("unroll") for (int k = 0; k < 2; ++k) dst[n][k] = *(const LAS bf16x8*)(lds + PG8_SB(b, h) + boff + n * 2048 + k * 1024); } while (0)
#define PG8_MMA(ai, bj, At, Bt) do { __builtin_amdgcn_s_setprio(1); _Pragma("unroll") for (int m = 0; m < 4; ++m) _Pragma("unroll") for (int n = 0; n < 2; ++n) _Pragma("unroll") for (int k = 0; k < 2; ++k) \
        acc[ai][bj][m][n] = __builtin_amdgcn_mfma_f32_16x16x32_bf16(Bt[n][k], At[m][k], acc[ai][bj][m][n], 0, 0, 0); __builtin_amdgcn_s_setprio(0); } while (0)
#define PG8_WAIT_V(n) asm volatile("s_waitcnt vmcnt(" #n ")" ::: "memory")
#define PG8_WAIT_L(n) asm volatile("s_waitcnt lgkmcnt(" #n ")" ::: "memory")
#define PG8_BAR __builtin_amdgcn_s_barrier()
#define PG8_SCHED __builtin_amdgcn_sched_barrier(0)
    Unit cur, nxt; int ui = 0;
    if (!S.next(0, cur)) return;
    f32x4 acc[2][2][4][2];
#pragma unroll
    for (int a = 0; a < 2; ++a)
#pragma unroll
        for (int b = 0; b < 2; ++b)
#pragma unroll
            for (int m = 0; m < 4; ++m)
#pragma unroll
                for (int n = 0; n < 2; ++n) acc[a][b][m][n] = (f32x4){0.f, 0.f, 0.f, 0.f};
    bf16x8 At[4][2], B0[2][2], B1[2][2];
    S.a_ready(cur);
    const char* cA = S.aptr(cur); const char* cB = S.bptr(cur);
    PG8_STAGE(PG8_SB(0, 0), cB, voffB); PG8_STAGE(PG8_SB(0, 1), cB + hstep, voffB); PG8_STAGE(PG8_SA(0, 0), cA, voffA); PG8_STAGE(PG8_SA(0, 1), cA + hstep, voffA);
    if (wr == 1) PG8_BAR;
    PG8_WAIT_V(2); PG8_BAR;
    PG8_STAGE(PG8_SB(1, 0), cB + kstep, voffB); PG8_STAGE(PG8_SA(1, 0), cA + kstep, voffA); PG8_STAGE(PG8_SB(1, 1), cB + hstep + kstep, voffB);
    PG8_WAIT_V(6); PG8_BAR;
    for (;;) {
        const bool has_next = S.next(ui + 1, nxt);
        const int nt = cur.nt;
        const char* nA = has_next ? S.aptr(nxt) : cA; const char* nB = has_next ? S.bptr(nxt) : cB;
        for (int t = 0; t < nt; t += 2) {
            const bool last = (t == nt - 2);
            const char* a1 = cA + (size_t)(t + 1) * kstep;
            const char* a2 = last ? nA : cA + (size_t)(t + 2) * kstep; const char* b2 = last ? nB : cB + (size_t)(t + 2) * kstep;
            const char* a3 = a2 + kstep; const char* b3 = b2 + kstep;
            if (last && has_next) S.a_ready(nxt);
            PG8_LDB(B0, 0, 0); PG8_LDB(B1, 0, 1); PG8_SCHED; PG8_LDA(At, 0, 0); PG8_STAGE(PG8_SA(1, 1), a1 + hstep, voffA);
            PG8_WAIT_V(8); PG8_WAIT_L(0); PG8_BAR; PG8_MMA(0, 0, At, B0); PG8_MMA(0, 1, At, B1); PG8_BAR; PG8_SCHED;
            PG8_LDA(At, 0, 1); PG8_STAGE(PG8_SB(0, 0), b2, voffB); PG8_STAGE(PG8_SB(0, 1), b2 + hstep, voffB); PG8_STAGE(PG8_SA(0, 0), a2, voffA);
            PG8_WAIT_V(8); PG8_WAIT_L(0); PG8_BAR; PG8_MMA(1, 0, At, B0); PG8_MMA(1, 1, At, B1); PG8_BAR; PG8_SCHED;
            PG8_LDB(B0, 1, 0); PG8_LDB(B1, 1, 1); PG8_SCHED; PG8_LDA(At, 1, 0); PG8_STAGE(PG8_SA(0, 1), a2 + hstep, voffA);
            PG8_WAIT_V(8); PG8_WAIT_L(0); PG8_BAR; PG8_MMA(0, 0, At, B0); PG8_MMA(0, 1, At, B1); PG8_BAR; PG8_SCHED;
            PG8_LDA(At, 1, 1); PG8_STAGE(PG8_SB(1, 0), b3, voffB); PG8_STAGE(PG8_SB(1, 1), b3 + hstep, voffB); PG8_STAGE(PG8_SA(1, 0), a3, voffA);
            PG8_WAIT_V(8); PG8_WAIT_L(0); PG8_BAR; PG8_MMA(1, 0, At, B0); PG8_MMA(1, 1, At, B1); PG8_BAR; PG8_SCHED;
        }
        if (wr == 0) PG8_BAR;
        E(acc, cur, wr, wc, fr, fq);
        if (!has_next) break;
#pragma unroll
        for (int a = 0; a < 2; ++a)
#pragma unroll
            for (int b = 0; b < 2; ++b)
#pragma unroll
                for (int m = 0; m < 4; ++m)
#pragma unroll
                    for (int n = 0; n < 2; ++n) acc[a][b][m][n] = (f32x4){0.f, 0.f, 0.f, 0.f};
        cur = nxt; cA = nA; cB = nB; ++ui;
        if (wr == 1) PG8_BAR;
    }
    PG8_WAIT_V(0);
    PG8_BAR;
#undef PG8_SA
#undef PG8_SB
#undef PG8_STAGE
#undef PG8_LDA
#undef PG8_LDB
#undef PG8_MMA
#undef PG8_WAIT_V
#undef PG8_WAIT_L
#undef PG8_BAR
#undef PG8_SCHED
}
}
using pg8::Unit;
typedef f32x4 Acc[2][2][4][2];

DI void store8bf(bf16_t* p, f32x4 a, f32x4 b) { u32x4 w; w.x = cvtpk(a[0], a[1]); w.y = cvtpk(a[2], a[3]); w.z = cvtpk(b[0], b[1]); w.w = cvtpk(b[2], b[3]); *(u32x4*)p = w; }

DI void wait_counter(const unsigned* ctr, unsigned target) {
    while (__hip_atomic_load(ctr, __ATOMIC_RELAXED, __HIP_MEMORY_SCOPE_AGENT) < target) __builtin_amdgcn_s_sleep(2);
    __builtin_amdgcn_fence(__ATOMIC_ACQUIRE, "agent");
}
struct SchedSimple {
    const char *A, *B; int nM, nN, G, c; size_t tstep; int ntk; const unsigned* ctr; unsigned target;
    DI bool next(int i, Unit& u) const { const long L = (long)i * G + c; if (L >= (long)nM * nN) return false; pg8::tile_map((int)L, nM, nN, u.pm, u.pn); u.z = 0; u.nt = ntk; u.kp = -1; return true; }
    DI const char* aptr(const Unit& u) const { return A + (size_t)u.pm * tstep; }
    DI const char* bptr(const Unit& u) const { return B + (size_t)u.pn * tstep; }
    DI void a_ready(const Unit& u) const { if (ctr && u.pm >= 128) wait_counter(ctr, target); }
};
struct SchedP1 {
    const char *A, *B, *A2, *B2; int G, c;
    DI bool next(int i, Unit& u) const { long L = (long)i * G + c; u.nt = 32; u.kp = -1; if (L < 130 * 50) { pg8::tile_map((int)L, 130, 50, u.pm, u.pn); u.z = 0; return true; }
        L -= 130 * 50; if (L < 32) { u.pm = (int)(L >> 3); u.pn = (int)(L & 7); u.z = 1; return true; } return false; }
    DI const char* aptr(const Unit& u) const { return (u.z ? A2 : A) + (size_t)u.pm * (256 * 2048 * 2); }
    DI const char* bptr(const Unit& u) const { return (u.z ? B2 : B) + (size_t)u.pn * (256 * 2048 * 2); }
    DI void a_ready(const Unit&) const {}
};
template <int NP>
struct SchedSplit {
    const char *A, *B; int G, c; int K; const unsigned* ctr; unsigned target; int pitch;
    DI bool next(int i, Unit& u) const {
        const int L = i * G + c; int pm, pn, nt, kp; bool ok = true;
        if (L < 1024) { pg8::tile_map(L, 128, 8, pm, pn); nt = K / 64; kp = -1; }
        else { const int P = L - 1024, tile = P / NP; kp = P % NP; pm = 128 + (tile >> 3); pn = tile & 7; nt = 8; ok = P < 16 * NP; }
        u.pm = pm; u.pn = pn; u.z = 0; u.nt = nt; u.kp = kp; return ok; }
    DI const char* aptr(const Unit& u) const { return A + ((size_t)u.pm * 256 * pitch + (u.kp > 0 ? u.kp * 512 : 0)) * 2; }
    DI const char* bptr(const Unit& u) const { return B + ((size_t)u.pn * 256 * pitch + (u.kp > 0 ? u.kp * 512 : 0)) * 2; }
    DI void a_ready(const Unit& u) const { if (ctr && u.pm >= 128) wait_counter(ctr, target); }
};
struct SchedMerge {
    const char *A0, *A1, *A2, *B; int G, c;
    DI bool next(int i, Unit& u) const {
        int pm, pn, z, nt, kp; bool ok = true;
        if (i < 12) { pg8::tile_map((i / 3) * 256 + c, 128, 8, pm, pn); z = i % 3; nt = 16; kp = -1; }
        else { const int L = (i - 12) * 256 + c, tile = L / 6, rem = L % 6; pm = 128 + (tile >> 3); pn = tile & 7; z = rem >> 1; kp = rem & 1; nt = 8; ok = L < 96; }
        u.pm = pm; u.pn = pn; u.z = z; u.nt = nt; u.kp = kp; return ok; }
    DI const char* aptr(const Unit& u) const { return (u.z == 0 ? A0 : (u.z == 1 ? A1 : A2)) + ((size_t)u.pm * 256 * 1024 + (u.kp > 0 ? 512 : 0)) * 2; }
    DI const char* bptr(const Unit& u) const { return B + (((size_t)u.z * 2048 + (size_t)u.pn * 256) * 1024 + (u.kp > 0 ? 512 : 0)) * 2; }
    DI void a_ready(const Unit&) const {}
};

struct EpiP1 {
    bf16_t *QS, *KS, *VS, *QR, *KR, *VR, *GR, *QM, *GT, *MK, *MV; const float* b_gate; float* out;
    DI void plain(const Acc& acc, bf16_t* O, int ld, int col0, int row0, float sc, int act) const {
#pragma unroll
        for (int ai = 0; ai < 2; ++ai)
#pragma unroll
            for (int m = 0; m < 4; ++m) { bf16_t* rowp = O + (size_t)(row0 + ai * 128 + m * 16) * ld + col0;
#pragma unroll
                for (int bj = 0; bj < 2; ++bj) { f32x4 v0 = acc[ai][bj][m][0] * sc, v1 = acc[ai][bj][m][1] * sc;
                    if (act == 1) {
#pragma unroll
                        for (int j = 0; j < 4; ++j) { v0[j] = silu_f(v0[j]); v1[j] = silu_f(v1[j]); } }
                    store8bf(rowp + bj * 128, v0, v1); } }
    }
    DI void operator()(const Acc& acc, const Unit& u, int wr, int wc, int fr, int fq) const {
        asm volatile("" : "+v"(fr), "+v"(fq));
        const int row0 = u.pm * 256 + wr * 64 + fr, cl = wc * 32 + 8 * fq;
        if (u.z == 1) {
            bf16_t* Ob = (u.pn < 4) ? MK : MV; float* Of = out + ((u.pn < 4) ? O_MEMK : O_MEMV); const int c0 = (u.pn & 3) * 256 + cl;
#pragma unroll
            for (int ai = 0; ai < 2; ++ai)
#pragma unroll
                for (int m = 0; m < 4; ++m) { const size_t r = (size_t)(row0 + ai * 128 + m * 16);
#pragma unroll
                    for (int bj = 0; bj < 2; ++bj) { store8bf(Ob + r * 1024 + c0 + bj * 128, acc[ai][bj][m][0], acc[ai][bj][m][1]);
                        *(f32x4*)(Of + r * 1024 + c0 + bj * 128) = acc[ai][bj][m][0]; *(f32x4*)(Of + r * 1024 + c0 + bj * 128 + 4) = acc[ai][bj][m][1]; } }
            return;
        }
        const int pn = u.pn;
        if (pn < 4) { plain(acc, QS, 1024, pn * 256 + cl, row0, 0.125f * LOG2E, 0); return; }
        if (pn < 6) {
            bf16_t* O = (pn == 4) ? KS : VS; plain(acc, O, 256, cl, row0, 1.f, 0);
            if (u.pm >= 128) {
                float* Of = out + ((pn == 4) ? O_SWAK_S : O_SWAV_S);
#pragma unroll
                for (int ai = 0; ai < 2; ++ai) { const int b = (u.pm - 128) * 4 + 2 * ai + wr;
#pragma unroll
                    for (int m = 0; m < 4; ++m) { float* rp = Of + ((size_t)b * 128 + 64 + 16 * m + fr) * 256 + cl;
#pragma unroll
                        for (int bj = 0; bj < 2; ++bj) { *(f32x4*)(rp + bj * 128) = acc[ai][bj][m][0]; *(f32x4*)(rp + bj * 128 + 4) = acc[ai][bj][m][1]; } } }
            } else if ((u.pm & 31) == 31) {
                float* Of = out + ((pn == 4) ? O_SWAK_P : O_SWAV_P); const int b = u.pm >> 5;
#pragma unroll
                for (int m = 0; m < 4; ++m) { float* rp = Of + ((size_t)b * 128 + 64 * wr + 16 * m + fr) * 256 + cl;
#pragma unroll
                    for (int bj = 0; bj < 2; ++bj) { *(f32x4*)(rp + bj * 128) = acc[1][bj][m][0]; *(f32x4*)(rp + bj * 128 + 4) = acc[1][bj][m][1]; } }
            }
            return;
        }
        if (pn < 14) {
            const bool isq = pn < 10; bf16_t* O = isq ? QR : KR; const int hb = 2 * (pn - (isq ? 6 : 10));
            const int i0 = 16 * wc + 4 * fq; float invf[4];
#pragma unroll
            for (int j = 0; j < 4; ++j) invf[j] = fexp2(-(float)(i0 + j) * (13.287712379549449f / 63.0f));
            const float lg0 = log2gamma(hb), lg1 = log2gamma(hb + 1);
#pragma unroll
            for (int ai = 0; ai < 2; ++ai)
#pragma unroll
                for (int m = 0; m < 4; ++m) {
                    const int row = row0 + ai * 128 + m * 16; const int nl = 16 * m + fr;
                    const float pos = (u.pm >= 128) ? (float)(1024 + nl) : (float)(row & 8191);
                    float cs[4], sn[4];
#pragma unroll
                    for (int j = 0; j < 4; ++j) { float rev = (pos * invf[j]) * 0.15915494309189535f; rev = rev - floorf(rev); cs[j] = __builtin_amdgcn_cosf(rev); sn[j] = __builtin_amdgcn_sinf(rev); }
#pragma unroll
                    for (int bj = 0; bj < 2; ++bj) {
                        const float e = (float)(nl + 1) * (bj ? lg1 : lg0);
                        const float sc = isq ? fexp2(e) : 0.08838834764831845f * fexp2(-e);
                        const f32x4 x1 = acc[ai][bj][m][0], x2 = acc[ai][bj][m][1]; f32x4 o1, o2;
#pragma unroll
                        for (int j = 0; j < 4; ++j) { o1[j] = (x1[j] * cs[j] - x2[j] * sn[j]) * sc; o2[j] = (x1[j] * sn[j] + x2[j] * cs[j]) * sc; }
                        store8bf(O + (size_t)row * 1024 + (hb + bj) * 128 + cl, o1, o2);
                    }
                }
            return;
        }
        if (pn < 18) { plain(acc, VR, 1024, (pn - 14) * 256 + cl, row0, 1.f, 0); return; }
        if (pn < 22) { plain(acc, GR, 1024, (pn - 18) * 256 + cl, row0, 1.f, 1); return; }
        if (pn < 26) { plain(acc, QM, 1024, (pn - 22) * 256 + cl, row0, 0.0625f * LOG2E, 0); return; }
        {
            const int c0 = (pn - 26) * 256 + cl; f32x4 bv[2][2];
#pragma unroll
            for (int bj = 0; bj < 2; ++bj)
#pragma unroll
                for (int n = 0; n < 2; ++n) bv[bj][n] = *(const f32x4*)(b_gate + c0 + bj * 128 + 4 * n);
#pragma unroll
            for (int ai = 0; ai < 2; ++ai)
#pragma unroll
                for (int m = 0; m < 4; ++m) {
                    u32x4 qw;
#pragma unroll
                    for (int bj = 0; bj < 2; ++bj) { f32x4 v0 = acc[ai][bj][m][0] + bv[bj][0], v1 = acc[ai][bj][m][1] + bv[bj][1];
#pragma unroll
                        for (int j = 0; j < 4; ++j) { v0[j] = sigm_f(v0[j]); v1[j] = sigm_f(v1[j]); }
                        const unsigned lo = (unsigned)(v0[0] * 255.f + 0.5f) | ((unsigned)(v0[1] * 255.f + 0.5f) << 8) | ((unsigned)(v0[2] * 255.f + 0.5f) << 16) | ((unsigned)(v0[3] * 255.f + 0.5f) << 24);
                        const unsigned hi = (unsigned)(v1[0] * 255.f + 0.5f) | ((unsigned)(v1[1] * 255.f + 0.5f) << 8) | ((unsigned)(v1[2] * 255.f + 0.5f) << 16) | ((unsigned)(v1[3] * 255.f + 0.5f) << 24);
                        if (bj == 0) { qw.x = lo; qw.y = hi; } else { qw.z = lo; qw.w = hi; } }
                    *(u32x4*)((unsigned char*)GT + ((size_t)u.pm * 24 + (pn - 26)) * 65536 + ((size_t)(((wr * 4 + wc) * 8 + ai * 4 + m) * 64 + fq * 16 + fr)) * 16) = qw; }
        }
    }
};

DI float gq(unsigned w, int j) { return (float)((w >> (8 * j)) & 255u) * (1.0f / 255.0f); }
struct EpiMerge {
    const bf16_t* GT; bf16_t* MG; float* MS32; bf16_t* T;
    DI void operator()(const Acc& acc, const Unit& u, int wr, int wc, int fr, int fq) const {
        asm volatile("" : "+v"(fr), "+v"(fq));
        const int row0 = u.pm * 256 + wr * 64 + fr, c0 = u.pn * 256 + wc * 32 + 8 * fq;
        bf16_t* Tp = T + ((size_t)((wr * 4 + wc) * 16) * 64 + fq * 16 + fr) * 8;
        if (u.kp >= 0) {
            float* P = MS32 + (size_t)(u.z * 2 + u.kp) * MS * DM;
#pragma unroll
            for (int ai = 0; ai < 2; ++ai) {
                u32x2 g[4][2];
#pragma unroll
                for (int m = 0; m < 4; ++m) { const u32x4 gw = *(const u32x4*)((const unsigned char*)GT + ((size_t)u.pm * 24 + u.z * 8 + u.pn) * 65536 + ((size_t)(((wr * 4 + wc) * 8 + ai * 4 + m) * 64 + fq * 16 + fr)) * 16); g[m][0] = (u32x2){gw.x, gw.y}; g[m][1] = (u32x2){gw.z, gw.w}; }
#pragma unroll
                for (int m = 0; m < 4; ++m)
#pragma unroll
                    for (int bj = 0; bj < 2; ++bj) { const u32x2 gg = g[m][bj]; float* d = P + (size_t)(row0 - MP + ai * 128 + m * 16) * 2048 + c0 + bj * 128;
                        f32x4 v0 = acc[ai][bj][m][0], v1 = acc[ai][bj][m][1];
                        v0[0] *= gq(gg.x, 0); v0[1] *= gq(gg.x, 1); v0[2] *= gq(gg.x, 2); v0[3] *= gq(gg.x, 3); v1[0] *= gq(gg.y, 0); v1[1] *= gq(gg.y, 1); v1[2] *= gq(gg.y, 2); v1[3] *= gq(gg.y, 3);
                        *(f32x4*)d = v0; *(f32x4*)(d + 4) = v1; }
                asm volatile("" ::: "memory");
            }
            return;
        }
#pragma unroll
        for (int ai = 0; ai < 2; ++ai) {
            u32x2 g[4][2]; u32x4 p[4][2];
#pragma unroll
            for (int m = 0; m < 4; ++m) { const u32x4 gw = *(const u32x4*)((const unsigned char*)GT + ((size_t)u.pm * 24 + u.z * 8 + u.pn) * 65536 + ((size_t)(((wr * 4 + wc) * 8 + ai * 4 + m) * 64 + fq * 16 + fr)) * 16); g[m][0] = (u32x2){gw.x, gw.y}; g[m][1] = (u32x2){gw.z, gw.w}; }
            if (u.z > 0) {
#pragma unroll
                for (int m = 0; m < 4; ++m)
#pragma unroll
                    for (int bj = 0; bj < 2; ++bj) p[m][bj] = *(const u32x4*)(Tp + (size_t)(ai * 8 + m * 2 + bj) * 512);
            } else {
#pragma unroll
                for (int m = 0; m < 4; ++m)
#pragma unroll
                    for (int bj = 0; bj < 2; ++bj) p[m][bj] = (u32x4){0u, 0u, 0u, 0u};
            }
#pragma unroll
            for (int m = 0; m < 4; ++m)
#pragma unroll
                for (int bj = 0; bj < 2; ++bj) {
                    const u32x2 gg = g[m][bj]; const u32x4 pp = p[m][bj];
                    f32x4 v0 = acc[ai][bj][m][0], v1 = acc[ai][bj][m][1];
                    v0[0] = v0[0] * gq(gg.x, 0) + bflo(pp.x); v0[1] = v0[1] * gq(gg.x, 1) + bfhi(pp.x); v0[2] = v0[2] * gq(gg.x, 2) + bflo(pp.y); v0[3] = v0[3] * gq(gg.x, 3) + bfhi(pp.y);
                    v1[0] = v1[0] * gq(gg.y, 0) + bflo(pp.z); v1[1] = v1[1] * gq(gg.y, 1) + bfhi(pp.z); v1[2] = v1[2] * gq(gg.y, 2) + bflo(pp.w); v1[3] = v1[3] * gq(gg.y, 3) + bfhi(pp.w);
                    if (u.z < 2) store8bf(Tp + (size_t)(ai * 8 + m * 2 + bj) * 512, v0, v1);
                    else store8bf(MG + (size_t)(row0 + ai * 128 + m * 16) * 2048 + c0 + bj * 128, v0, v1);
                }
            asm volatile("" ::: "memory");
        }
    }
};

DI void partial_tile(const Acc& acc, float* P, int rows0, int c0) {
#pragma unroll
    for (int ai = 0; ai < 2; ++ai)
#pragma unroll
        for (int m = 0; m < 4; ++m)
#pragma unroll
            for (int bj = 0; bj < 2; ++bj) { float* d = P + (size_t)(rows0 + ai * 128 + m * 16) * DM + c0 + bj * 128; *(f32x4*)d = acc[ai][bj][m][0]; *(f32x4*)(d + 4) = acc[ai][bj][m][1]; }
}
struct EpiWo {
    const float* xp; float* PART; bf16_t* H1B; float* ss1;
    DI void operator()(const Acc& acc, const Unit& u, int wr, int wc, int fr, int fq) const {
        const int row0 = u.pm * 256 + wr * 64 + fr, c0 = u.pn * 256 + wc * 32 + 8 * fq;
        if (u.kp >= 0) { partial_tile(acc, PART + (size_t)u.kp * MS * DM, row0 - MP, c0); return; }
#pragma unroll
        for (int ai = 0; ai < 2; ++ai) {
            f32x4 xv[4][2][2];
#pragma unroll
            for (int m = 0; m < 4; ++m)
#pragma unroll
                for (int bj = 0; bj < 2; ++bj) { const size_t o = (size_t)(row0 + ai * 128 + m * 16) * DM + c0 + bj * 128; xv[m][bj][0] = *(const f32x4*)(xp + o); xv[m][bj][1] = *(const f32x4*)(xp + o + 4); }
#pragma unroll
            for (int m = 0; m < 4; ++m) { const size_t r = (size_t)(row0 + ai * 128 + m * 16); float s = 0.f;
#pragma unroll
                for (int bj = 0; bj < 2; ++bj) { const size_t o = r * DM + c0 + bj * 128;
                    const f32x4 v0 = acc[ai][bj][m][0] + xv[m][bj][0], v1 = acc[ai][bj][m][1] + xv[m][bj][1];
                    store8bf(H1B + o, v0, v1);
                    s += (v0[0] * v0[0] + v0[1] * v0[1]) + (v0[2] * v0[2] + v0[3] * v0[3]) + (v1[0] * v1[0] + v1[1] * v1[1]) + (v1[2] * v1[2] + v1[3] * v1[3]); }
                s += __shfl_xor(s, 16); s += __shfl_xor(s, 32);
                if (fq == 0) atomicAdd(ss1 + r, s); }
            asm volatile("" ::: "memory");
        }
    }
};

struct EpiDown {
    float* PART; bf16_t* H1B;
    DI void operator()(const Acc& acc, const Unit& u, int wr, int wc, int fr, int fq) const {
        const int row0 = u.pm * 256 + wr * 64 + fr, c0 = u.pn * 256 + wc * 32 + 8 * fq;
        if (u.kp >= 0) { partial_tile(acc, PART + (size_t)u.kp * MS * DM, row0 - MP, c0); return; }
#pragma unroll
        for (int ai = 0; ai < 2; ++ai) {
            u32x4 hv[4][2];
#pragma unroll
            for (int m = 0; m < 4; ++m)
#pragma unroll
                for (int bj = 0; bj < 2; ++bj) hv[m][bj] = *(const u32x4*)(H1B + (size_t)(row0 + ai * 128 + m * 16) * DM + c0 + bj * 128);
#pragma unroll
            for (int m = 0; m < 4; ++m)
#pragma unroll
                for (int bj = 0; bj < 2; ++bj) { const u32x4 h = hv[m][bj]; f32x4 v0 = acc[ai][bj][m][0], v1 = acc[ai][bj][m][1];
                    v0[0] += bflo(h.x); v0[1] += bfhi(h.x); v0[2] += bflo(h.y); v0[3] += bfhi(h.y); v1[0] += bflo(h.z); v1[1] += bfhi(h.z); v1[2] += bflo(h.w); v1[3] += bfhi(h.w);
                    store8bf(H1B + (size_t)(row0 + ai * 128 + m * 16) * DM + c0 + bj * 128, v0, v1); }
            asm volatile("" ::: "memory");
        }
    }
};

template <int CTRL> DI float dpp_ror(float v) { return __builtin_bit_cast(float, __builtin_amdgcn_update_dpp(0, __builtin_bit_cast(int, v), CTRL, 0xf, 0xf, false)); }

struct EpiUp {
    const float *ss1, *w_conv, *b_conv, *sconv; bf16_t* ACT; float* RAW; float* out; LAS unsigned char* xl;
    template <int GV>
    DI void conv_cols(const Acc& acc, const Unit& u, int ai, int n, int G, int f, int fr, const float (&rs)[4], bool samp, int sb, const f32x4 (&cw)[4], f32x4 (&cg)[4], bf16_t* actp) const {
        f32x4 X[4];
#pragma unroll
        for (int m = 0; m < 4; ++m) X[m] = acc[ai][GV][m][n] * rs[m];
        f32x4 Hh = (f32x4){0.f, 0.f, 0.f, 0.f};
        if (samp) { if (fr >= 14) Hh = *(const f32x4*)(sconv + ((size_t)sb * 2 + (fr - 14)) * FF2 + GV * FF + f); }
        else {
            float* rw = RAW + ((((size_t)u.pm * 4 + G) * 4) * 2 + GV) * FF + f;
            if (fr < 2 || fr >= 14) *(f32x4*)(rw + (size_t)(fr < 2 ? fr : fr - 12) * 2 * FF) = (fr < 2) ? X[0] : X[3];
        }
        if (fr >= 14) {
            if (samp) *(f32x4*)(out + O_CONV_S + ((size_t)sb * 2 + (fr - 14)) * FF2 + GV * FF + f) = X[3];
            else if ((u.pm & 31) == 31 && G == 3) *(f32x4*)(out + O_CONV_P + ((size_t)(u.pm >> 5) * 2 + (fr - 14)) * FF2 + GV * FF + f) = X[3];
        }
#pragma unroll
        for (int m = 0; m < 4; ++m) {
            f32x4 p1, p2;
#pragma unroll
            for (int j = 0; j < 4; ++j) {
                const float prev = (m == 0) ? Hh[j] : X[m - 1][j];
                const float a1 = dpp_ror<0x121>(X[m][j]), b1 = dpp_ror<0x121>(prev);
                const float a2 = dpp_ror<0x122>(X[m][j]), b2 = dpp_ror<0x122>(prev);
                p1[j] = (fr >= 1) ? a1 : b1; p2[j] = (fr >= 2) ? a2 : b2;
            }
            const f32x4 c = cw[3] + cw[0] * p2 + cw[1] * p1 + cw[2] * X[m];
            if (GV == 0) cg[m] = c;
            else { u32x2 wv; wv.x = cvtpk(silu_f(cg[m][0]) * c[0], silu_f(cg[m][1]) * c[1]); wv.y = cvtpk(silu_f(cg[m][2]) * c[2], silu_f(cg[m][3]) * c[3]);
                *(u32x2*)(actp + (size_t)(m * 16) * FFP) = wv; }
        }
    }
    DI void operator()(const Acc& acc, const Unit& u, int wr, int wc, int fr, int fq) const {
        asm volatile("" : "+v"(fr), "+v"(fq));
        const int row0 = u.pm * 256 + wr * 64 + fr; const int f0 = u.pn * 128 + wc * 32 + 8 * fq; const bool samp = u.pm >= 128;
        {
            const int t = (wr * 4 + wc) * 64 + fq * 16 + fr;
            LAS float* cwl = (LAS float*)xl; LAS float* ssl = cwl + 1024;
            if (t < 256) { const int q = t >> 5, f4 = (t & 31) * 4, gv = q >> 2, tap = q & 3;
                *(LAS f32x4*)(cwl + q * 128 + f4) = *(const f32x4*)((tap < 3 ? w_conv + (size_t)tap * FF2 : b_conv) + gv * FF + u.pn * 128 + f4); }
            else if (t < 320) *(LAS f32x4*)(ssl + (t - 256) * 4) = *(const f32x4*)(ss1 + (size_t)u.pm * 256 + (t - 256) * 4);
            asm volatile("s_waitcnt lgkmcnt(0)" ::: "memory");
            __builtin_amdgcn_s_barrier();
            asm volatile("" ::: "memory");
        }
        const LAS float* cwl = (const LAS float*)xl; const LAS float* ssl = cwl + 1024;
        float rs[2][4];
#pragma unroll
        for (int ai = 0; ai < 2; ++ai)
#pragma unroll
            for (int m = 0; m < 4; ++m) rs[ai][m] = rsqrtf(ssl[wr * 64 + fr + ai * 128 + m * 16] * (1.0f / DM) + EPS);
#pragma unroll
        for (int n = 0; n < 2; ++n) {
            const int f = f0 + 4 * n; const int fl = wc * 32 + 8 * fq + 4 * n;
            f32x4 cwg[4], cwv[4];
#pragma unroll
            for (int t = 0; t < 4; ++t) { cwg[t] = *(const LAS f32x4*)(cwl + t * 128 + fl); cwv[t] = *(const LAS f32x4*)(cwl + (4 + t) * 128 + fl); }
#pragma unroll
            for (int ai = 0; ai < 2; ++ai) {
                const int G = 2 * ai + wr; const int sb = (u.pm - 128) * 4 + G;
                f32x4 cg[4];
                conv_cols<0>(acc, u, ai, n, G, f, fr, rs[ai], samp, sb, cwg, cg, nullptr);
                conv_cols<1>(acc, u, ai, n, G, f, fr, rs[ai], samp, sb, cwv, cg, ACT + (size_t)(row0 + ai * 128) * FFP + f);
            }
            asm volatile("" ::: "memory");
        }
    }
};

DI int dest_row(int mode, int n) {
    if (mode == 1) { if (n >= 1536 && n < 3584) { const int hd = (n - 1536) >> 7, d = (n - 1536) & 127, half = d >> 6, i = d & 63; return 1536 + hd * 128 + 8 * (i >> 2) + 4 * half + (i & 3); } return n; }
    if (mode == 2) { const int gv = n >= FF ? 1 : 0, f = n - gv * FF; return 256 * (f >> 7) + 128 * gv + (f & 127); }
    return n;
}
DI void p0_transpose_item(const float* W, int K, int N, bf16_t* WT, int mode, const float* kscale, LAS float* scr, int item, int lane, int pitch = 0) {
    if (pitch == 0) pitch = K;
    const int nblk = N / 32, kb = item / nblk, nb = item % nblk, k0 = 64 * kb, n0 = 32 * nb;
    f32x4 wv[8];
#pragma unroll
    for (int i = 0; i < 8; ++i) wv[i] = *(const f32x4*)(W + (size_t)(k0 + 8 * i + (lane >> 3)) * N + n0 + 4 * (lane & 7));
    if (kscale) {
#pragma unroll
        for (int i = 0; i < 8; ++i) wv[i] = wv[i] * kscale[k0 + 8 * i + (lane >> 3)]; }
#pragma unroll
    for (int i = 0; i < 8; ++i) { LAS float* d = scr + (8 * i + (lane >> 3)) * 33 + 4 * (lane & 7); d[0] = wv[i][0]; d[1] = wv[i][1]; d[2] = wv[i][2]; d[3] = wv[i][3]; }
    asm volatile("s_waitcnt lgkmcnt(0)" ::: "memory");
    const int c = lane & 7;
#pragma unroll
    for (int j = 0; j < 4; ++j) { const int n = (lane >> 3) + 8 * j; const LAS float* s = scr + (8 * c) * 33 + n;
        u32x4 o; o.x = cvtpk(s[0 * 33], s[1 * 33]); o.y = cvtpk(s[2 * 33], s[3 * 33]); o.z = cvtpk(s[4 * 33], s[5 * 33]); o.w = cvtpk(s[6 * 33], s[7 * 33]);
        *(u32x4*)(WT + (size_t)dest_row(mode, n0 + n) * pitch + k0 + 8 * c) = o; }
    asm volatile("s_waitcnt lgkmcnt(0)" ::: "memory");
}
DI void rms_row_to_bf16(const float* xrow, const float* g, bf16_t* orow, int lane) {
    f32x4 v[8]; float s = 0.f;
#pragma unroll
    for (int j = 0; j < 8; ++j) { v[j] = *((const f32x4*)xrow + lane + 64 * j); s += (v[j][0] * v[j][0] + v[j][1] * v[j][1]) + (v[j][2] * v[j][2] + v[j][3] * v[j][3]); }
    const float rstd = rsqrtf(wave_sum(s) * (1.0f / DM) + EPS);
#pragma unroll
    for (int j = 0; j < 8; ++j) { const f32x4 gg = *((const f32x4*)g + lane + 64 * j); u32x2 w; w.x = cvtpk(v[j][0] * rstd * gg[0], v[j][1] * rstd * gg[1]); w.y = cvtpk(v[j][2] * rstd * gg[2], v[j][3] * rstd * gg[3]);
        *((u32x2*)orow + lane + 64 * j) = w; }
}
DI void rms_row_to_bf16_g(const float* xrow, const f32x4 (&gg)[8], bf16_t* orow, int lane) {
    f32x4 v[8]; float s = 0.f;
#pragma unroll
    for (int j = 0; j < 8; ++j) { v[j] = *((const f32x4*)xrow + lane + 64 * j); s += (v[j][0] * v[j][0] + v[j][1] * v[j][1]) + (v[j][2] * v[j][2] + v[j][3] * v[j][3]); }
    const float rstd = rsqrtf(wave_sum(s) * (1.0f / DM) + EPS);
#pragma unroll
    for (int j = 0; j < 8; ++j) { u32x2 w; w.x = cvtpk(v[j][0] * rstd * gg[j][0], v[j][1] * rstd * gg[j][1]); w.y = cvtpk(v[j][2] * rstd * gg[j][2], v[j][3] * rstd * gg[j][3]);
        *((u32x2*)orow + lane + 64 * j) = w; }
}
DI int dorig(int p) { return 64 * ((p >> 2) & 1) + 4 * (p >> 3) + (p & 3); }

DI void p0_prologue(const Ctx& C, LAS unsigned char* lds, int wave, bool first) {
    const int lane = lane_id(), tid = wave * 64 + lane;
    LAS float* scr = (LAS float*)(lds + wave * 16384);
    const int gw = blockIdx.x * 8 + wave, NGW = gridDim.x * 8;
    const int gt = blockIdx.x * 512 + tid, NGT = gridDim.x * 512;
    constexpr int I_IN = 32 * 400, I_BR = 16 * 64, I_O = 32 * 64, I_MEM = 32 * 64, I_UP = 32 * 352, I_DN = 88 * 64;
    constexpr int NITEMS = I_IN + 3 * I_BR + I_O + I_MEM + I_UP + I_DN;
    bf16_t* ws16 = (bf16_t*)C.ws;
    for (int it = gw; it < NITEMS; it += NGW) {
        int r = it;
        if (r < I_IN) { p0_transpose_item(C.w_in, DM, NIN, (bf16_t*)(C.ws + WS_WIN), 1, nullptr, scr, r, lane); continue; } r -= I_IN;
        if (r < 3 * I_BR) { const int z = r / I_BR; p0_transpose_item(C.w_br + (size_t)z * 1024 * DM, 1024, DM, (bf16_t*)(C.ws + WS_WBR) + (size_t)z * DM * 1024, 0, nullptr, scr, r % I_BR, lane); continue; } r -= 3 * I_BR;
        if (r < I_O) { p0_transpose_item(C.w_o, DM, DM, (bf16_t*)(C.ws + WS_WO), 0, nullptr, scr, r, lane); continue; } r -= I_O;
        if (r < I_MEM) { p0_transpose_item(C.w_mem, DM, DM, (bf16_t*)(C.ws + WS_WMEM), 0, nullptr, scr, r, lane); continue; } r -= I_MEM;
        if (r < I_UP) { p0_transpose_item(C.w_up, DM, FF2, (bf16_t*)(C.ws + WS_WUP), 2, C.g_ffn, scr, r, lane); continue; } r -= I_UP;
        p0_transpose_item(C.w_down, FF, DM, (bf16_t*)(C.ws + WS_WDN), 0, nullptr, scr, r, lane, FFP);
    }
    (void)ws16;
    bf16_t* U = (bf16_t*)C.out;
    {
        f32x4 gmix[8];
#pragma unroll
        for (int j = 0; j < 8; ++j) gmix[j] = *((const f32x4*)C.g_mix + lane + 64 * j);
        for (int m = gw; m < MT; m += NGW) rms_row_to_bf16_g(m < MP ? C.xp + (size_t)m * DM : C.xs + (size_t)(m - MP) * DM, gmix, U + (size_t)m * DM, lane);
        for (int m = gw; m < 1024; m += NGW) rms_row_to_bf16(C.memp + (size_t)m * DM, C.g_mem, (bf16_t*)(C.ws + WS_MEMN) + (size_t)m * DM, lane);
    }
    for (int i = gt; i < 2 * 8 * 256 * 128; i += NGT) { const int which = i >= 8 * 256 * 128, e = (i - which * 8 * 256 * 128) * 8;
        const float* src = (which ? C.cmemv : C.cmemk) + e; bf16_t* dst = (bf16_t*)(C.ws + (which ? WS_MV : WS_MK)) + (size_t)1024 * 1024 + e;
        store8bf(dst, *(const f32x4*)src, *(const f32x4*)(src + 4)); }
    for (int i = gt; i < 2 * 8 * 64 * 64; i += NGT) { const int which = i >= 8 * 64 * 64, j = i - which * 8 * 64 * 64, b = j >> 12, rem = j & 4095;
        const float* src = (which ? C.cswav : C.cswak) + ((size_t)b * 128 + 64) * 256 + rem * 4; float* dst = C.out + (which ? O_SWAV_S : O_SWAK_S) + (size_t)b * 128 * 256 + rem * 4;
        *(f32x4*)dst = *(const f32x4*)src; }
    for (int i = gt; i < 64 * 16 * 128; i += NGT) {
        const int bh = i >> 11, p8 = (i >> 7) & 15, e = i & 127;
        float v[8];
#pragma unroll
        for (int k = 0; k < 8; ++k) v[k] = C.sret[((size_t)bh * 128 + dorig(8 * p8 + k)) * 128 + e];
        u32x4 o; o.x = cvtpk(v[0], v[1]); o.y = cvtpk(v[2], v[3]); o.z = cvtpk(v[4], v[5]); o.w = cvtpk(v[6], v[7]);
        *(u32x4*)((bf16_t*)(C.ws + WS_S0T) + ((size_t)bh * 128 + e) * 128 + 8 * p8) = o; }
    float* ss = (float*)(C.ws + WS_CTL);
    for (int i = gt; i < 2 * MT; i += NGT) ss[i] = 0.f;
    if (gt == 0) { if (first) *(unsigned*)(C.ws + WS_BAR) = 0u; *(unsigned*)(C.ws + WS_BAR + 256) = 0u; *(unsigned*)(C.ws + WS_BAR + 512) = 0u; }
}

#define MFMA32(a, b, c) __builtin_amdgcn_mfma_f32_32x32x16_bf16((a), (b), (c), 0, 0, 0)
typedef short v4i16_t __attribute__((ext_vector_type(4)));
DI s16x4 tr_read(const LAS unsigned char* p) { return __builtin_bit_cast(s16x4, __builtin_amdgcn_ds_read_tr16_b64_v4i16((LAS v4i16_t*)p)); }
DI bf16x8 tr_pair(const LAS unsigned char* tile, int stride, int rlo, int rhi, int col0, int lane) {
    const int q4 = (lane & 15) >> 2, p = lane & 3, blk = (lane >> 4) & 1;
    const s16x4 lo = tr_read(tile + (rlo + q4) * stride + (col0 + 16 * blk + 4 * p) * 2);
    const s16x4 hi = tr_read(tile + (rhi + q4) * stride + (col0 + 16 * blk + 4 * p) * 2);
    return __builtin_shufflevector(lo, hi, 0, 1, 2, 3, 4, 5, 6, 7);
}
DI bf16x8 pack_step(const f32x16& x, int s) {
    u32x4 p; p.x = cvtpk(x[8 * s], x[8 * s + 1]); p.y = cvtpk(x[8 * s + 2], x[8 * s + 3]); p.z = cvtpk(x[8 * s + 4], x[8 * s + 5]); p.w = cvtpk(x[8 * s + 6], x[8 * s + 7]);
    return __builtin_bit_cast(bf16x8, p);
}
DI void store_pair16(bf16_t* rowp, u32x2 a, u32x2 b, int g, int hh) {
    auto r0 = __builtin_amdgcn_permlane32_swap(a.x, b.x, false, false); a.x = r0[0]; b.x = r0[1];
    auto r1 = __builtin_amdgcn_permlane32_swap(a.y, b.y, false, false); a.y = r1[0]; b.y = r1[1];
    *(u32x4*)(rowp + 8 * g + 8 * hh) = (u32x4){a.x, a.y, b.x, b.y};
}
DI void store_block32(bf16_t* rowp, const f32x16& o, float sc, int hh) {
#pragma unroll
    for (int g = 0; g < 4; g += 2) {
        u32x2 a, b;
        a.x = cvtpk(o[4 * g] * sc, o[4 * g + 1] * sc); a.y = cvtpk(o[4 * g + 2] * sc, o[4 * g + 3] * sc);
        b.x = cvtpk(o[4 * g + 4] * sc, o[4 * g + 5] * sc); b.y = cvtpk(o[4 * g + 6] * sc, o[4 * g + 7] * sc);
        store_pair16(rowp, a, b, g, hh);
    }
}
DI int crow(int i, int h) { return (i & 3) + 8 * (i >> 2) + 4 * h; }
DI f32x16 zero16() { f32x16 z; for (int i = 0; i < 16; ++i) z[i] = 0.f; return z; }
DI size_t seq_rowbase(int sq) { return sq < 4 ? (size_t)sq * 8192 : (size_t)MP + (size_t)(sq - 4) * 64; }

DI void swa_unit(const Ctx& C, LAS unsigned char* lds, int sq, int hk, int c, int w) {
    const int lane = lane_id(), tid = w * 64 + lane, r = lane & 31, hh = lane >> 5;
    constexpr int KSTR = 144;
    LAS unsigned char* Kt = lds; LAS unsigned char* Vt = lds + 192 * KSTR;
    const bool samp = sq >= 4;
    const size_t rowbase = seq_rowbase(sq) + (size_t)c * 64;
    const bf16_t* KS = (const bf16_t*)(C.ws + WS_KS); const bf16_t* VS = (const bf16_t*)(C.ws + WS_VS); bf16_t* QS = (bf16_t*)(C.ws + WS_QS);
    for (int i = tid; i < 192 * 8; i += 512) {
        const int row = i >> 3, ch = i & 7, j = row >> 6, rr = row & 63;
        u32x4 kv = (u32x4){0u, 0u, 0u, 0u}, vv = kv;
        if (samp && j < 2) {
            const size_t o = (((size_t)(sq - 4) * 128 + row) * 4 + hk) * 64 + ch * 8;
            const f32x4 k0 = *(const f32x4*)(C.cswak + o), k1 = *(const f32x4*)(C.cswak + o + 4), v0 = *(const f32x4*)(C.cswav + o), v1 = *(const f32x4*)(C.cswav + o + 4);
            kv.x = cvtpk(k0[0], k0[1]); kv.y = cvtpk(k0[2], k0[3]); kv.z = cvtpk(k1[0], k1[1]); kv.w = cvtpk(k1[2], k1[3]);
            vv.x = cvtpk(v0[0], v0[1]); vv.y = cvtpk(v0[2], v0[3]); vv.z = cvtpk(v1[0], v1[1]); vv.w = cvtpk(v1[2], v1[3]);
        } else {
            const int cc = samp ? 0 : c - 2 + j;
            if (cc >= 0) { const size_t gr = seq_rowbase(sq) + (size_t)cc * 64 + rr; kv = *(const u32x4*)(KS + gr * 256 + hk * 64 + ch * 8); vv = *(const u32x4*)(VS + gr * 256 + hk * 64 + ch * 8); }
        }
        *(LAS u32x4*)(Kt + row * KSTR + ch * 16) = kv; *(LAS u32x4*)(Vt + row * KSTR + ch * 16) = vv;
    }
    const int g = w >> 1, half = w & 1, head = hk * 4 + g;
    bf16_t* qp = QS + (rowbase + 32 * half + r) * 1024 + head * 64;
    bf16x8 qf[4];
#pragma unroll
    for (int s = 0; s < 4; ++s) qf[s] = *(const bf16x8*)(qp + 16 * s + 8 * hh);
    __syncthreads();
    const int kb0 = samp ? 0 : (c >= 2 ? 0 : (2 - c) * 2);
    f32x16 acc[6];
#pragma unroll
    for (int kb = 0; kb < 6; ++kb) { acc[kb] = zero16();
        if (kb >= kb0) {
#pragma unroll
            for (int s = 0; s < 4; ++s) { const bf16x8 a = *(const LAS bf16x8*)(Kt + (32 * kb + r) * KSTR + (16 * s + 8 * hh) * 2); acc[kb] = MFMA32(a, qf[s], acc[kb]); } } }
    const float sk = C.sink[head] * LOG2E;
    float mx = sk;
#pragma unroll
    for (int kb = 0; kb < 6; ++kb) if (kb >= kb0) {
#pragma unroll
        for (int i = 0; i < 16; ++i) mx = fmaxf(mx, acc[kb][i]); }
    mx = fmaxf(mx, __shfl_xor(mx, 32));
    float l = 0.f;
#pragma unroll
    for (int kb = 0; kb < 6; ++kb) if (kb >= kb0) {
#pragma unroll
        for (int i = 0; i < 16; ++i) { const float p = fexp2(acc[kb][i] - mx); acc[kb][i] = p; l += p; } }
    l += __shfl_xor(l, 32); l += fexp2(sk - mx);
    f32x16 o[2]; o[0] = zero16(); o[1] = zero16();
#pragma unroll
    for (int kb = 0; kb < 6; ++kb) if (kb >= kb0) {
#pragma unroll
        for (int s = 0; s < 2; ++s) { const bf16x8 pb = pack_step(acc[kb], s); const int r0 = 32 * kb + 16 * s + 4 * hh;
#pragma unroll
            for (int db = 0; db < 2; ++db) { const bf16x8 a = tr_pair(Vt, KSTR, r0, r0 + 8, 32 * db, lane); o[db] = MFMA32(a, pb, o[db]); } } }
    const float inv = 1.0f / l;
#pragma unroll
    for (int db = 0; db < 2; ++db) store_block32(qp + 32 * db, o[db], inv, hh);
    __syncthreads();
}

DI void mem_unit(const Ctx& C, LAS unsigned char* lds, int sq, int h, int qt, int w) {
    const int lane = lane_id(), tid = w * 64 + lane, r = lane & 31, hh = lane >> 5;
    constexpr int MSTR = 272;
    const bool samp = sq >= 4;
    const size_t qrow = samp ? seq_rowbase(sq) + 32 * (w & 1) + r : seq_rowbase(sq) + (size_t)qt * 256 + 32 * w + r;
    const bool do_store = !samp || w < 2;
    bf16_t* qp = (bf16_t*)(C.ws + WS_QM) + qrow * 1024 + h * 256;
    const bf16_t* Kg = (const bf16_t*)(C.ws + WS_MK) + (size_t)sq * 256 * 1024 + h * 256; const bf16_t* Vg = (const bf16_t*)(C.ws + WS_MV) + (size_t)sq * 256 * 1024 + h * 256;
    f32x16 acc[8];
#pragma unroll
    for (int mb = 0; mb < 8; ++mb) acc[mb] = zero16();
#pragma unroll 1
    for (int dh = 0; dh < 2; ++dh) {
        __syncthreads();
        for (int i = tid; i < 256 * 16; i += 512) { const int row = i >> 4, ch = i & 15; *(LAS u32x4*)(lds + row * MSTR + ch * 16) = *(const u32x4*)(Kg + (size_t)row * 1024 + dh * 128 + ch * 8); }
        bf16x8 qf[8];
#pragma unroll
        for (int s = 0; s < 8; ++s) qf[s] = *(const bf16x8*)(qp + dh * 128 + 16 * s + 8 * hh);
        __syncthreads();
#pragma unroll
        for (int mb = 0; mb < 8; ++mb)
#pragma unroll
            for (int s = 0; s < 8; ++s) { const bf16x8 a = *(const LAS bf16x8*)(lds + (32 * mb + r) * MSTR + (16 * s + 8 * hh) * 2); acc[mb] = MFMA32(a, qf[s], acc[mb]); }
    }
    float mx = -3.0e38f;
#pragma unroll
    for (int mb = 0; mb < 8; ++mb)
#pragma unroll
        for (int i = 0; i < 16; ++i) mx = fmaxf(mx, acc[mb][i]);
    mx = fmaxf(mx, __shfl_xor(mx, 32));
    float l = 0.f; bf16x8 pb[16];
#pragma unroll
    for (int mb = 0; mb < 8; ++mb) {
#pragma unroll
        for (int i = 0; i < 16; ++i) { const float p = fexp2(acc[mb][i] - mx); acc[mb][i] = p; l += p; }
        pb[2 * mb] = pack_step(acc[mb], 0); pb[2 * mb + 1] = pack_step(acc[mb], 1); }
    l += __shfl_xor(l, 32);
    const float inv = 1.0f / l;
#pragma unroll 1
    for (int dh = 0; dh < 2; ++dh) {
        __syncthreads();
        for (int i = tid; i < 256 * 16; i += 512) { const int row = i >> 4, ch = i & 15; *(LAS u32x4*)(lds + row * MSTR + ch * 16) = *(const u32x4*)(Vg + (size_t)row * 1024 + dh * 128 + ch * 8); }
        __syncthreads();
        f32x16 o[4];
#pragma unroll
        for (int db = 0; db < 4; ++db) o[db] = zero16();
#pragma unroll
        for (int ks = 0; ks < 16; ++ks) { const int r0 = 32 * (ks >> 1) + 16 * (ks & 1) + 4 * hh;
#pragma unroll
            for (int db = 0; db < 4; ++db) { const bf16x8 a = tr_pair(lds, MSTR, r0, r0 + 8, 32 * db, lane); o[db] = MFMA32(a, pb[ks], o[db]); } }
        if (do_store) {
#pragma unroll
            for (int db = 0; db < 4; ++db) store_block32(qp + dh * 128 + 32 * db, o[db], inv, hh); }
    }
    __syncthreads();
}

DI bf16_t* ut_ptr(const Ctx& C, int sq, int h, int c) { const size_t idx = sq < 4 ? ((size_t)(sq * 8 + h) * 128 + c) : (size_t)4096 + (size_t)(sq - 4) * 8 + h; return (bf16_t*)C.out + idx * 16384; }
DI void stage_rows128(LAS unsigned char* dst, const bf16_t* src, int nrows, int tid) {
    for (int i = tid; i < nrows * 16; i += 512) { const int row = i >> 4, ch = i & 15; *(LAS u32x4*)(dst + row * 272 + ch * 16) = *(const u32x4*)(src + (size_t)row * 1024 + ch * 8); }
}
DI void retA_unit(const Ctx& C, LAS unsigned char* lds, int sq, int h, int c, int w) {
    const int lane = lane_id(), tid = w * 64 + lane, r = lane & 31, hh = lane >> 5;
    constexpr int RSTR = 272;
    LAS unsigned char* Kt = lds; LAS unsigned char* Vt = lds + 64 * RSTR;
    const size_t rowbase = seq_rowbase(sq) + (size_t)c * 64;
    stage_rows128(Kt, (const bf16_t*)(C.ws + WS_KR) + rowbase * 1024 + h * 128, 64, tid);
    stage_rows128(Vt, (const bf16_t*)(C.ws + WS_VR) + rowbase * 1024 + h * 128, 64, tid);
    __syncthreads();
    const int eb = w >> 1, db0 = (w & 1) * 2;
    f32x16 acc[2]; acc[0] = zero16(); acc[1] = zero16();
#pragma unroll
    for (int s = 0; s < 4; ++s) { const int r0 = 16 * s + 8 * hh;
        const bf16x8 b = tr_pair(Vt, RSTR, r0, r0 + 4, 32 * eb, lane);
#pragma unroll
        for (int x = 0; x < 2; ++x) { const bf16x8 a = tr_pair(Kt, RSTR, r0, r0 + 4, 32 * (db0 + x), lane); acc[x] = MFMA32(a, b, acc[x]); } }
    bf16_t* U = ut_ptr(C, sq, h, c) + (size_t)(32 * eb + r) * 128;
#pragma unroll
    for (int x = 0; x < 2; ++x) store_block32(U + 32 * (db0 + x), acc[x], 1.0f, hh);
    __syncthreads();
}

DI void ret_scan(const Ctx& C, int wave) {
    const int tid = wave * 64 + lane_id();
    const int gt = blockIdx.x * 512 + tid, NGT = gridDim.x * 512;
    for (int it = gt; it < 32 * 4096 + 64 * 4096; it += NGT) {
        if (it < 32 * 4096) {
            const int bh = it >> 12, e = (it >> 5) & 127, p0 = (it & 31) * 4, h = bh & 7;
            const float g64 = fexp2(64.f * log2gamma(h));
            bf16_t* U = (bf16_t*)C.out + (size_t)bh * 128 * 16384 + e * 128 + p0;
            float s0 = 0.f, s1 = 0.f, s2 = 0.f, s3 = 0.f;
#pragma unroll 1
            for (int c0 = 0; c0 < 128; c0 += 16) {
                u32x2 u[16];
#pragma unroll
                for (int k = 0; k < 16; ++k) u[k] = *(const u32x2*)(U + (size_t)(c0 + k) * 16384);
#pragma unroll
                for (int k = 0; k < 16; ++k) { s0 = g64 * (s0 + bflo(u[k].x)); s1 = g64 * (s1 + bfhi(u[k].x)); s2 = g64 * (s2 + bflo(u[k].y)); s3 = g64 * (s3 + bfhi(u[k].y));
                    u32x2 wv; wv.x = cvtpk(s0, s1); wv.y = cvtpk(s2, s3); *(u32x2*)(U + (size_t)(c0 + k) * 16384) = wv; }
            }
            float* O = C.out + O_RET_P + (size_t)bh * 16384 + e;
            O[(size_t)dorig(p0) * 128] = s0; O[(size_t)dorig(p0 + 1) * 128] = s1; O[(size_t)dorig(p0 + 2) * 128] = s2; O[(size_t)dorig(p0 + 3) * 128] = s3;
        } else {
            const int j = it - 32 * 4096, bh = j >> 12, e = (j >> 5) & 127, p0 = (j & 31) * 4, h = bh & 7;
            const float g64 = fexp2(64.f * log2gamma(h));
            const u32x2 u = *(const u32x2*)((const bf16_t*)C.out + ((size_t)4096 + bh) * 16384 + e * 128 + p0);
            const float uu[4] = {bflo(u.x), bfhi(u.x), bflo(u.y), bfhi(u.y)};
#pragma unroll
            for (int k = 0; k < 4; ++k) { const size_t o = ((size_t)bh * 128 + dorig(p0 + k)) * 128 + e; C.out[O_RET_S + o] = g64 * (C.sret[o] + uu[k]); }
        }
    }
}

struct RetCRegs { u32x4 kvq[6]; u32x4 st[4]; };
DI void retC_decode(int u, int& sq, int& h, int& c) { if (u < 4096) { sq = u >> 10; h = (u >> 7) & 7; c = u & 127; } else { const int x = u - 4096; sq = 4 + (x >> 3); h = x & 7; c = 0; } }
DI void retC_get(const Ctx& C, int u, int tid, RetCRegs& R) {
    int sq, h, c; retC_decode(u, sq, h, c);
    const size_t rowbase = seq_rowbase(sq) + (size_t)c * 64; const bool samp = sq >= 4, has_prev = samp || c > 0;
    const bf16_t* Kg = (const bf16_t*)(C.ws + WS_KR) + rowbase * 1024 + h * 128; const bf16_t* Vg = (const bf16_t*)(C.ws + WS_VR) + rowbase * 1024 + h * 128; const bf16_t* Qg = (const bf16_t*)(C.ws + WS_QR) + rowbase * 1024 + h * 128;
#pragma unroll
    for (int k = 0; k < 2; ++k) { const int i = tid + 512 * k, row = i >> 4, ch = i & 15; const size_t o = (size_t)row * 1024 + ch * 8;
        R.kvq[k] = *(const u32x4*)(Kg + o); R.kvq[2 + k] = *(const u32x4*)(Vg + o); R.kvq[4 + k] = *(const u32x4*)(Qg + o); }
    if (has_prev) { const bf16_t* S = samp ? (const bf16_t*)(C.ws + WS_S0T) + (size_t)((sq - 4) * 8 + h) * 16384 : ut_ptr(C, sq, h, c - 1);
#pragma unroll
        for (int k = 0; k < 4; ++k) { const int i = tid + 512 * k, row = i >> 4, ch = i & 15; R.st[k] = *(const u32x4*)(S + (size_t)row * 128 + ch * 8); } }
    else {
#pragma unroll
        for (int k = 0; k < 4; ++k) R.st[k] = (u32x4){0u, 0u, 0u, 0u}; }
}
DI void retC_put(LAS unsigned char* lds, int tid, const RetCRegs& R) {
    constexpr int RSTR = 272;
#pragma unroll
    for (int k = 0; k < 2; ++k) { const int i = tid + 512 * k, row = i >> 4, ch = i & 15;
        *(LAS u32x4*)(lds + row * RSTR + ch * 16) = R.kvq[k]; *(LAS u32x4*)(lds + (64 + row) * RSTR + ch * 16) = R.kvq[2 + k]; *(LAS u32x4*)(lds + (128 + row) * RSTR + ch * 16) = R.kvq[4 + k]; }
#pragma unroll
    for (int k = 0; k < 4; ++k) { const int i = tid + 512 * k, row = i >> 4, ch = i & 15; *(LAS u32x4*)(lds + (192 + row) * RSTR + ch * 16) = R.st[k]; }
}
DI void retC_unit(const Ctx& C, LAS unsigned char* lds, int sq, int h, int c, int w) {
    const int lane = lane_id(), tid = w * 64 + lane, r = lane & 31, hh = lane >> 5;
    constexpr int RSTR = 272;
    LAS unsigned char* Kt = lds; LAS unsigned char* Vt = lds + 64 * RSTR; LAS unsigned char* Qt = lds + 128 * RSTR; LAS unsigned char* St = lds + 192 * RSTR;
    LAS float* red = (LAS float*)(lds + 320 * RSTR);
    const size_t rowbase = seq_rowbase(sq) + (size_t)c * 64;
    const bool samp = sq >= 4, has_prev = samp || c > 0;
    bf16_t* QR = (bf16_t*)(C.ws + WS_QR);
    const int nh = w & 1, eq = w >> 1;
    bf16x8 qf[8];
#pragma unroll
    for (int s = 0; s < 8; ++s) qf[s] = *(const LAS bf16x8*)(Qt + (32 * nh + r) * RSTR + (16 * s + 8 * hh) * 2);
    f32x16 o = zero16();
#pragma unroll
    for (int mb = 0; mb < 2; ++mb) if (mb <= nh) {
        f32x16 P = zero16();
#pragma unroll
        for (int s = 0; s < 8; ++s) { const bf16x8 a = *(const LAS bf16x8*)(Kt + (32 * mb + r) * RSTR + (16 * s + 8 * hh) * 2); P = MFMA32(a, qf[s], P); }
        if (mb == nh) {
#pragma unroll
            for (int i = 0; i < 16; ++i) if (crow(i, hh) > r) P[i] = 0.f; }
#pragma unroll
        for (int s = 0; s < 2; ++s) { const bf16x8 pb = pack_step(P, s); const int r0 = 32 * mb + 16 * s + 4 * hh; const bf16x8 a = tr_pair(Vt, RSTR, r0, r0 + 8, 32 * eq, lane); o = MFMA32(a, pb, o); }
    }
    if (has_prev) {
#pragma unroll
        for (int s = 0; s < 8; ++s) { const bf16x8 a = *(const LAS bf16x8*)(St + (32 * eq + r) * RSTR + (16 * s + 8 * hh) * 2); o = MFMA32(a, qf[s], o); } }
    float ss = 0.f;
#pragma unroll
    for (int i = 0; i < 16; ++i) ss += o[i] * o[i];
    ss += __shfl_xor(ss, 32);
    if (hh == 0) red[(32 * nh + r) * 4 + eq] = ss;
    __syncthreads();
    const f32x4 rr = *(const LAS f32x4*)(red + (32 * nh + r) * 4);
    const float rstd = rsqrtf(((rr[0] + rr[1]) + (rr[2] + rr[3])) * (1.0f / 128.0f) + EPS);
    const size_t orow = (rowbase + 32 * nh + r) * 1024 + h * 128 + 32 * eq;
    const bf16_t* GR = (const bf16_t*)(C.ws + WS_GR);
    u32x2 gt[4];
#pragma unroll
    for (int g4 = 0; g4 < 4; ++g4) gt[g4] = *(const u32x2*)(GR + orow + 8 * g4 + 4 * hh);
#pragma unroll
    for (int g = 0; g < 4; g += 2) { u32x2 a, b;
        a.x = cvtpk(o[4 * g] * rstd * bflo(gt[g].x), o[4 * g + 1] * rstd * bfhi(gt[g].x)); a.y = cvtpk(o[4 * g + 2] * rstd * bflo(gt[g].y), o[4 * g + 3] * rstd * bfhi(gt[g].y));
        b.x = cvtpk(o[4 * g + 4] * rstd * bflo(gt[g + 1].x), o[4 * g + 5] * rstd * bfhi(gt[g + 1].x)); b.y = cvtpk(o[4 * g + 6] * rstd * bflo(gt[g + 1].y), o[4 * g + 7] * rstd * bfhi(gt[g + 1].y));
        store_pair16(QR + orow, a, b, g, hh); }
    __syncthreads();
}

DI void conv_fixup(const Ctx& C, int wave) {
    const int tid = wave * 64 + lane_id();
    const int gt = blockIdx.x * 512 + tid;
    const float* RAW = (const float*)(C.ws + WS_RAW); bf16_t* ACT = (bf16_t*)(C.ws + WS_ACT);
    constexpr int F4 = FF / 4;
    const int fc = gt % F4, g0 = gt / F4, f = fc * 4;
    f32x4 w0[2], w1[2], w2[2], bb[2];
#pragma unroll
    for (int gv = 0; gv < 2; ++gv) { w0[gv] = *(const f32x4*)(C.w_conv + gv * FF + f); w1[gv] = *(const f32x4*)(C.w_conv + FF2 + gv * FF + f); w2[gv] = *(const f32x4*)(C.w_conv + 2 * FF2 + gv * FF + f); bb[gv] = *(const f32x4*)(C.b_conv + gv * FF + f); }
    for (int grp = g0; grp < 512; grp += 93) {
        if ((grp & 127) == 0) continue;
        const float* cur = RAW + (size_t)grp * 4 * 2 * FF + f; const float* prv = RAW + (size_t)(grp - 1) * 4 * 2 * FF + f;
        f32x4 c0[2], c1[2];
#pragma unroll
        for (int gv = 0; gv < 2; ++gv) {
            const f32x4 p62 = *(const f32x4*)(prv + (size_t)(2 * 2 + gv) * FF), p63 = *(const f32x4*)(prv + (size_t)(3 * 2 + gv) * FF), a0 = *(const f32x4*)(cur + (size_t)(0 * 2 + gv) * FF), a1 = *(const f32x4*)(cur + (size_t)(1 * 2 + gv) * FF);
            c0[gv] = bb[gv] + w0[gv] * p62 + w1[gv] * p63 + w2[gv] * a0; c1[gv] = bb[gv] + w0[gv] * p63 + w1[gv] * a0 + w2[gv] * a1;
        }
        u32x2 o0, o1;
        o0.x = cvtpk(silu_f(c0[0][0]) * c0[1][0], silu_f(c0[0][1]) * c0[1][1]); o0.y = cvtpk(silu_f(c0[0][2]) * c0[1][2], silu_f(c0[0][3]) * c0[1][3]);
        o1.x = cvtpk(silu_f(c1[0][0]) * c1[1][0], silu_f(c1[0][1]) * c1[1][1]); o1.y = cvtpk(silu_f(c1[0][2]) * c1[1][2], silu_f(c1[0][3]) * c1[1][3]);
        *(u32x2*)(ACT + (size_t)(grp * 64) * FFP + f) = o0; *(u32x2*)(ACT + (size_t)(grp * 64 + 1) * FFP + f) = o1;
    }
}

DI void conv_merged_s(const Ctx& C, int wave) {
    const int gw = blockIdx.x * 8 + wave, lane = lane_id();
    if (gw < MS) {
        const f32x4* s = (const f32x4*)C.out + (size_t)gw * (DM / 4); u32x2* d = (u32x2*)((bf16_t*)(C.ws + WS_MERGED) + (size_t)(MP + gw) * DM);
#pragma unroll
        for (int j = 0; j < 8; ++j) { f32x4 v = s[lane + 64 * j];
#pragma unroll
            for (int q = 1; q < 6; ++q) v += s[(size_t)q * (MS * DM / 4) + lane + 64 * j];
            u32x2 w; w.x = cvtpk(v[0], v[1]); w.y = cvtpk(v[2], v[3]); d[lane + 64 * j] = w; }
        asm volatile("s_waitcnt vmcnt(0)" ::: "memory");
        __builtin_amdgcn_fence(__ATOMIC_RELEASE, "agent");
        if (lane == 0) __hip_atomic_fetch_add((unsigned*)(C.ws + WS_BAR + 256), 1u, __ATOMIC_RELAXED, __HIP_MEMORY_SCOPE_AGENT);
    }
}
DI void conv_h_s(const Ctx& C, int wave) {
    const int gw = blockIdx.x * 8 + wave, lane = lane_id();
    if (gw < MS) {
        const f32x4* s = (const f32x4*)C.out + (size_t)gw * (DM / 4); const f32x4* x = (const f32x4*)C.xs + (size_t)gw * (DM / 4);
        f32x4* h = (f32x4*)(C.out + (size_t)(MP + gw) * DM); u32x2* d = (u32x2*)((bf16_t*)(C.ws + WS_H1B) + (size_t)(MP + gw) * DM); float ss = 0.f;
#pragma unroll
        for (int j = 0; j < 8; ++j) { f32x4 v = x[lane + 64 * j];
#pragma unroll
            for (int q = 0; q < 4; ++q) v += s[(size_t)q * (MS * DM / 4) + lane + 64 * j];
            h[lane + 64 * j] = v; u32x2 w; w.x = cvtpk(v[0], v[1]); w.y = cvtpk(v[2], v[3]); d[lane + 64 * j] = w; ss += (v[0] * v[0] + v[1] * v[1]) + (v[2] * v[2] + v[3] * v[3]); }
        ss = wave_sum(ss);
        if (lane == 0) ((float*)(C.ws + WS_CTL))[MP + gw] = ss;
        asm volatile("s_waitcnt vmcnt(0)" ::: "memory");
        __builtin_amdgcn_fence(__ATOMIC_RELEASE, "agent");
        if (lane == 0) __hip_atomic_fetch_add((unsigned*)(C.ws + WS_BAR + 512), 1u, __ATOMIC_RELAXED, __HIP_MEMORY_SCOPE_AGENT);
    }
}
DI void final_norm(const Ctx& C, int wave) {
    const int lane = lane_id();
    const int gw = blockIdx.x * 8 + wave, NGW = gridDim.x * 8;
    f32x4 gfin[8];
#pragma unroll
    for (int j = 0; j < 8; ++j) gfin[j] = *((const f32x4*)C.g_final + lane + 64 * j);
    for (int m = gw; m < MT; m += NGW) {
        f32x4* row = (f32x4*)(C.out + (size_t)m * DM);
        f32x4 v[8]; float s = 0.f;
        if (m < MP) {
            const u32x2* hb = (const u32x2*)((const bf16_t*)(C.ws + WS_H1B) + (size_t)m * DM);
#pragma unroll
            for (int j = 0; j < 8; ++j) { const u32x2 h = hb[lane + 64 * j]; v[j] = (f32x4){bflo(h.x), bfhi(h.x), bflo(h.y), bfhi(h.y)}; }
        } else {
            const f32x4* pd = (const f32x4*)(C.ws + WS_VR) + (size_t)(m - MP) * (DM / 4);
#pragma unroll
            for (int j = 0; j < 8; ++j) { v[j] = row[lane + 64 * j];
#pragma unroll
                for (int q = 0; q < 11; ++q) v[j] += pd[(size_t)q * (MS * DM / 4) + lane + 64 * j]; }
        }
#pragma unroll
        for (int j = 0; j < 8; ++j) s += (v[j][0] * v[j][0] + v[j][1] * v[j][1]) + (v[j][2] * v[j][2] + v[j][3] * v[j][3]);
        const float rstd = rsqrtf(wave_sum(s) * (1.0f / DM) + EPS);
#pragma unroll
        for (int j = 0; j < 8; ++j) row[lane + 64 * j] = v[j] * rstd * gfin[j];
    }
}

#define XB_TMO      128
#define XB_XCNT(j)  (256  + 64 * (j))
#define XB_XSUB(j)  (1280 + 64 * (j))
#define XB_XGEN(j)  (2304 + 64 * (j))
#define XB_TOP      3328
#define XB_TOPGEN   3392
#define XCD_BAR_WORDS 3456
#define XB_SPIN_CAP (1u << 18)
constexpr size_t WS_XBAR = 768 * 1024;
DI unsigned xb_ld(unsigned* p)              { return __hip_atomic_load(p, __ATOMIC_RELAXED, __HIP_MEMORY_SCOPE_AGENT); }
DI unsigned xb_add(unsigned* p, unsigned v) { return __hip_atomic_fetch_add(p, v, __ATOMIC_RELAXED, __HIP_MEMORY_SCOPE_AGENT); }
DI unsigned xb_xcc_id() { return (unsigned)__builtin_amdgcn_s_getreg((3 << 11) | 20) & 0xFu; }
#define XB_SPIN(cond, bar) do { unsigned _sp = 0; while (cond) { __builtin_amdgcn_s_sleep(1); \
    if ((++_sp & 255u) == 0u) { if (xb_ld(&(bar)[XB_TMO])) break; if (_sp > XB_SPIN_CAP) { atomicAdd(&(bar)[XB_TMO], 1u); break; } } } } while (0)
struct XcdBarrier { unsigned* bar; unsigned x; volatile LAS unsigned* st; };
DI void xcd_barrier_complete(unsigned* bar, unsigned x, unsigned& nloc, unsigned& nx) {
    const unsigned G = gridDim.x;
    unsigned sum, cnt, mine, sp = 0u;
    for (;;) {
        sum = 0u; cnt = 0u; mine = 0u;
#pragma unroll
        for (unsigned j = 0; j < 16; ++j) { const unsigned c = xb_ld(&bar[XB_XCNT(j)]); sum += c; cnt += (c > 0u) ? 1u : 0u; mine = (j == x) ? c : mine; }
        if (sum == G) break;
        __builtin_amdgcn_s_sleep(1);
        if ((++sp & 255u) == 0u) { if (xb_ld(&bar[XB_TMO])) break; if (sp > XB_SPIN_CAP) { atomicAdd(&bar[XB_TMO], 1u); break; } }
    }
    nloc = mine > 0u ? mine : 1u; nx = cnt > 0u ? cnt : 1u;
}
DI void xcd_barrier(const XcdBarrier& b, int wave) {
    asm volatile("s_waitcnt vmcnt(0)" ::: "memory");
    __syncthreads();
    if (wave == 0 && lane_id() == 0) {
        unsigned* bar = b.bar;
        __builtin_amdgcn_s_waitcnt(0);
        unsigned nloc = b.st[0], nx = b.st[1];
        if (nloc == 0u) { xcd_barrier_complete(bar, b.x, nloc, nx); b.st[0] = nloc; b.st[1] = nx; }
        const unsigned old = xb_add(&bar[XB_XSUB(b.x)], 1u);
        const unsigned gen = old / nloc;
        if (old + 1u == (gen + 1u) * nloc) {
            __builtin_amdgcn_fence(__ATOMIC_RELEASE, "agent");
            asm volatile("s_waitcnt vmcnt(0)" ::: "memory");
            const unsigned og = xb_add(&bar[XB_TOP], 1u);
            const unsigned tg = og / nx;
            if (og + 1u == (tg + 1u) * nx) xb_add(&bar[XB_TOPGEN], 1u);
            else XB_SPIN(xb_ld(&bar[XB_TOPGEN]) == tg, bar);
            __builtin_amdgcn_fence(__ATOMIC_ACQUIRE, "agent");
            xb_add(&bar[XB_XGEN(b.x)], 1u);
            asm volatile("s_waitcnt vmcnt(0)" ::: "memory");
        } else {
            XB_SPIN(xb_ld(&bar[XB_XGEN(b.x)]) == gen, bar);
            __builtin_amdgcn_fence(__ATOMIC_ACQUIRE, "agent");
            asm volatile("s_waitcnt vmcnt(0)" ::: "memory");
        }
    }
    __syncthreads();
}

constexpr int LDS_BYTES = 147456;
#define MKCTX Ctx C; C.xp = args.in[0]; C.xs = args.in[1]; C.memp = args.in[2]; C.cswak = args.in[3]; C.cswav = args.in[4]; C.sret = args.in[5]; C.sconv = args.in[6]; C.cmemk = args.in[7]; C.cmemv = args.in[8]; C.g_mix = args.in[9]; C.w_in = args.in[10]; C.b_gate = args.in[11]; C.sink = args.in[12]; C.w_br = args.in[13]; C.w_o = args.in[14]; C.g_mem = args.in[15]; C.w_mem = args.in[16]; C.g_ffn = args.in[17]; C.w_up = args.in[18]; C.w_conv = args.in[19]; C.b_conv = args.in[20]; C.w_down = args.in[21]; C.g_final = args.in[22]; C.out = args.out; C.ws = args.ws;
__global__ void __launch_bounds__(512, 2) fwd(Args args) {
    extern __shared__ __attribute__((aligned(16))) unsigned char lds_raw[];
    LAS unsigned char* lds = (LAS unsigned char*)lds_raw;
    cg::grid_group grid = cg::this_grid();
    const int wave = __builtin_amdgcn_readfirstlane(threadIdx.x >> 6);
    XcdBarrier xbar; xbar.bar = (unsigned*)(args.ws + WS_XBAR); xbar.x = xb_xcc_id(); xbar.st = (volatile LAS unsigned*)(lds + 131072 + 64);
    if (wave == 0 && lane_id() == 0) { xbar.st[0] = 0u; xbar.st[1] = 0u; (void)xb_add(&xbar.bar[XB_XCNT(xbar.x)], 1u); }
    __syncthreads();
#ifndef PROBE_PREFIX
#define PROBE_PREFIX 0
#endif
    const int G = gridDim.x, bid = blockIdx.x;
    for (int pass = (PROBE_PREFIX ? 0 : 1); pass < 2; ++pass) {
    const int lo = 0, hi = (pass == 0) ? PROBE_PREFIX : 11;
#ifndef PH_MASK
#define PH_MASK 0x7ff
#endif
#define IN(k) (((PH_MASK >> (k)) & 1) && lo <= (k) && (k) < hi)
#ifndef REP_MASK
#define REP_MASK 0
#endif
#define SEAM(k) do { if (!IN(k)) break; if ((k) == 0) grid.sync(); else xcd_barrier(xbar, wave); } while (0)
#define NREP(k) (1 + ((REP_MASK >> (k)) & 1))
    if (IN(0)) { MKCTX; p0_prologue(C, lds, wave, pass == (PROBE_PREFIX ? 0 : 1)); }
    SEAM(0);
    if (IN(1)) {
        MKCTX;
        SchedP1 S{(const char*)C.out, (const char*)(C.ws + WS_WIN), (const char*)(C.ws + WS_MEMN), (const char*)(C.ws + WS_WMEM), G, bid};
        EpiP1 E{(bf16_t*)(C.ws + WS_QS), (bf16_t*)(C.ws + WS_KS), (bf16_t*)(C.ws + WS_VS), (bf16_t*)(C.ws + WS_QR), (bf16_t*)(C.ws + WS_KR), (bf16_t*)(C.ws + WS_VR), (bf16_t*)(C.ws + WS_GR),
                (bf16_t*)(C.ws + WS_QM), (bf16_t*)(C.ws + WS_GT), (bf16_t*)(C.ws + WS_MK), (bf16_t*)(C.ws + WS_MV), C.b_gate, C.out};
        pg8::gemm_phase(lds, DM, S, E, wave);
    }
    SEAM(1);
    if (IN(2)) {
        MKCTX;
        constexpr int N_MEM = 544, N_SWA = 2080, N_RA = 4160;
        for (int u = bid; u < N_MEM + N_SWA + N_RA; u += G) {
            if (u < N_MEM) { if (u < 512) mem_unit(C, lds, u >> 7, (u >> 5) & 3, u & 31, wave); else { const int v = u - 512; mem_unit(C, lds, 4 + (v >> 2), v & 3, 0, wave); } }
            else if (u < N_MEM + N_SWA) { const int v = u - N_MEM; if (v < 2048) swa_unit(C, lds, v >> 9, (v >> 7) & 3, v & 127, wave); else { const int x = v - 2048; swa_unit(C, lds, 4 + (x >> 2), x & 3, 0, wave); } }
            else { const int v = u - N_MEM - N_SWA; if (v < 4096) retA_unit(C, lds, v >> 10, (v >> 7) & 7, v & 127, wave); else { const int x = v - 4096; retA_unit(C, lds, 4 + (x >> 3), x & 7, 0, wave); } }
        }
    }
    SEAM(2);
    if (IN(3)) { MKCTX; ret_scan(C, wave); }
    SEAM(3);
    if (IN(4)) {
        MKCTX;
        {
            const int tid = wave * 64 + lane_id();
            RetCRegs R;
            if (bid < 4160) retC_get(C, bid, tid, R);
            for (int u = bid; u < 4160; u += G) {
                retC_put(lds, tid, R);
                __syncthreads();
                if (u + G < 4160) retC_get(C, u + G, tid, R);
                int sq, h, c; retC_decode(u, sq, h, c);
                retC_unit(C, lds, sq, h, c, wave);
            }
        }
    }
    SEAM(4);
    if (IN(5)) {
        MKCTX;
        SchedMerge S{(const char*)(C.ws + WS_QS), (const char*)(C.ws + WS_QR), (const char*)(C.ws + WS_QM), (const char*)(C.ws + WS_WBR), G, bid};
        EpiMerge E{(const bf16_t*)(C.ws + WS_GT), (bf16_t*)(C.ws + WS_MERGED), C.out, (bf16_t*)(C.ws + WS_GR) + (size_t)bid * 65536};
        pg8::gemm_phase(lds, 1024, S, E, wave);
    }
    SEAM(5);
    if (IN(6)) {
        MKCTX;
        conv_merged_s(C, wave);
        SchedSplit<4> S{(const char*)(C.ws + WS_MERGED), (const char*)(C.ws + WS_WO), G, bid, DM, (const unsigned*)(C.ws + WS_BAR + 256), (unsigned)MS, DM};
        EpiWo E{C.xp, C.out, (bf16_t*)(C.ws + WS_H1B), (float*)(C.ws + WS_CTL)};
        pg8::gemm_phase(lds, DM, S, E, wave);
    }
    SEAM(6);
    if (IN(7)) {
        MKCTX;
        conv_h_s(C, wave);
        SchedSimple S{(const char*)(C.ws + WS_H1B), (const char*)(C.ws + WS_WUP), 130, 44, G, bid, (size_t)256 * DM * 2, 32, (const unsigned*)(C.ws + WS_BAR + 512), (unsigned)MS};
        EpiUp E{(const float*)(C.ws + WS_CTL), C.w_conv, C.b_conv, C.sconv, (bf16_t*)(C.ws + WS_ACT), (float*)(C.ws + WS_RAW), C.out, lds + 131072 + 1024};
        pg8::gemm_phase(lds, DM, S, E, wave);
    }
    SEAM(7);
    if (IN(8)) { MKCTX; conv_fixup(C, wave); }
    SEAM(8);
    if (IN(9)) {
        MKCTX;
        SchedSplit<11> S{(const char*)(C.ws + WS_ACT), (const char*)(C.ws + WS_WDN), G, bid, FF, nullptr, 0u, FFP};
        EpiDown E{(float*)(C.ws + WS_VR), (bf16_t*)(C.ws + WS_H1B)};
        pg8::gemm_phase(lds, FFP, S, E, wave);
    }
    SEAM(9);
    if (IN(10)) { MKCTX; final_norm(C, wave); }
    if (pass == 0) SEAM(10);
    }
#undef IN
#undef SEAM
}

extern "C" void kernel_launch(void* const* d_in, const int* in_sizes, int n_in, void* d_out, int out_size, void* d_ws, size_t ws_size, hipStream_t stream) {
    static int grid = 0;
    if (grid == 0) {
        if (n_in != 23 || (size_t)out_size != O_END || ws_size < WS_END) { fprintf(stderr, "kernel_launch: unexpected shapes n_in %d out %d ws %zu\n", n_in, out_size, ws_size); grid = -1; return; }
        int dev = 0, cus = 0, per_cu = 0;
        (void)hipGetDevice(&dev);
        (void)hipDeviceGetAttribute(&cus, hipDeviceAttributeMultiprocessorCount, dev);
        (void)hipFuncSetAttribute((const void*)fwd, hipFuncAttributeMaxDynamicSharedMemorySize, LDS_BYTES);
        (void)hipOccupancyMaxActiveBlocksPerMultiprocessor(&per_cu, (const void*)fwd, 512, LDS_BYTES);
        if (per_cu < 1) per_cu = 1;
        grid = cus * per_cu;
        if (grid != 256) { fprintf(stderr, "kernel_launch: this kernel is laid out for 256 workgroups (one per CU); got %d\n", grid); grid = -1; return; }
    }
    if (grid < 0) return;
    (void)hipMemsetAsync((char*)d_ws + WS_XBAR, 0, XCD_BAR_WORDS * 4, stream);
    Args a{};
    for (int i = 0; i < 23; ++i) a.in[i] = (const float*)d_in[i];
    a.out = (float*)d_out; a.ws = (unsigned char*)d_ws; a.ph_lo = 0; a.ph_hi = 11;
    void* args[] = {&a};
    hipError_t e = hipLaunchCooperativeKernel((const void*)fwd, dim3(grid), dim3(512), args, LDS_BYTES, stream);
    if (e != hipSuccess) fprintf(stderr, "cooperative launch failed: %s (grid %d)\n", hipGetErrorString(e), grid);
}
```
